# Optimizing an MI355X kernel written in HIP

```python
import math
import jax, jax.numpy as jnp
from jax import lax
import numpy as np

D_MODEL = 2048
BATCH = 16
SEQ = 2048
DEPTH = 2

CHUNK = 64
N_META = 16
META_PAD = (-N_META) % CHUNK
D_HG = D_MODEL // 2
HG_HEADS = 8
HG_DK = D_HG // HG_HEADS
D_S5 = D_MODEL - D_HG
S5_GROUP = 16
S5_GROUPS = D_S5 // S5_GROUP
S5_STATE = 64
D_IN = 4 * D_HG + D_S5
D_FF = 5632
CONV_W = 3
EPS = 1e-6
F_FLOOR = 1e-6
DT_MIN = 1e-3
DT_MAX = 1e-1

kernel_name = "hymba_hgrn2_s5_convffn_block"


def rmsnorm(x, g):
    xf = x.astype(jnp.float32)
    y = xf * lax.rsqrt(jnp.mean(xf * xf, axis=-1, keepdims=True) + EPS)
    return (y * g.astype(jnp.float32)).astype(x.dtype)


def hgrn2_mixer(q, f_logit, i, g_out, lb, gain):
    f32 = jnp.float32
    b_sz, seq_len, _ = q.shape
    z = f_logit.astype(f32)
    lb = lb.astype(f32)
    f = lb + (1.0 - lb) * jax.nn.sigmoid(z)
    log_f = jnp.log(jnp.maximum(f, F_FLOOR))
    k = (1.0 - lb) * jax.nn.sigmoid(-z)
    qf = jax.nn.silu(q.astype(f32))
    v = i.astype(f32)
    lp = seq_len + META_PAD
    n_chunks = lp // CHUNK

    def to_chunks(t):
        t = jnp.pad(t, ((0, 0), (META_PAD, 0), (0, 0)))
        return t.reshape(b_sz, n_chunks, CHUNK, HG_HEADS, HG_DK).transpose(1, 0, 3, 2, 4)

    causal = jnp.tril(jnp.ones((CHUNK, CHUNK), dtype=bool))[:, :, None]

    def step(state, inp):
        qc, kc, vc, gc = inp
        b = jnp.cumsum(gc, axis=2)
        b_last = b[:, :, -1:, :]
        o_inter = jnp.einsum('bhtd,bhde->bhte', qc * jnp.exp(b), state)
        diff = b[:, :, :, None, :] - b[:, :, None, :, :]
        decay = jnp.exp(jnp.where(causal, diff, -jnp.inf))
        scores = jnp.einsum('bhtd,bhsd,bhtsd->bhts', qc, kc, decay)
        o_intra = jnp.einsum('bhts,bhse->bhte', scores, vc)
        new_state = (jnp.exp(b_last[:, :, 0, :])[..., None] * state
                     + jnp.einsum('bhsd,bhse->bhde', kc * jnp.exp(b_last - b), vc))
        return new_state, o_inter + o_intra

    s0 = jnp.zeros((b_sz, HG_HEADS, HG_DK, HG_DK), f32)
    _, o = lax.scan(step, s0, (to_chunks(qf), to_chunks(k), to_chunks(v), to_chunks(log_f)))
    o = o.transpose(1, 0, 3, 2, 4).reshape(b_sz, lp, HG_HEADS, HG_DK)[:, META_PAD:]
    o = o * lax.rsqrt(jnp.mean(o * o, axis=-1, keepdims=True) + EPS) * gain.astype(f32).reshape(HG_HEADS, HG_DK)
    return o.reshape(b_sz, seq_len, D_HG) * jax.nn.silu(g_out.astype(f32))


def _complex_scan_combine(e1, e2):
    a1r, a1i, b1r, b1i = e1
    a2r, a2i, b2r, b2i = e2
    ar = a2r * a1r - a2i * a1i
    ai = a2r * a1i + a2i * a1r
    a2r_, a2i_ = a2r[:, None], a2i[:, None]
    br = a2r_ * b1r - a2i_ * b1i + b2r
    bi = a2r_ * b1i + a2i_ * b1r + b2i
    return (ar, ai, br, bi)


def s5_mixer(u, lam_re, lam_im, log_step, b_re, b_im, c_re, c_im, d_skip, w_glu, b_glu, gain):
    f32 = jnp.float32
    b_sz, seq_len, _ = u.shape
    uf = u.astype(f32)
    ug = uf.reshape(b_sz, seq_len, S5_GROUPS, S5_GROUP)
    a_re = jnp.minimum(lam_re.astype(f32), -1e-4)
    a_im = lam_im.astype(f32)
    dt = jnp.exp(log_step.astype(f32))[:, None]
    mag = jnp.exp(a_re * dt)
    ab_re = mag * jnp.cos(a_im * dt)
    ab_im = mag * jnp.sin(a_im * dt)
    den = a_re * a_re + a_im * a_im
    x_re, x_im = ab_re - 1.0, ab_im
    z_re = (x_re * a_re + x_im * a_im) / den
    z_im = (x_im * a_re - x_re * a_im) / den
    br, bi = b_re.astype(f32), b_im.astype(f32)
    bb_re = z_re[..., None] * br - z_im[..., None] * bi
    bb_im = z_re[..., None] * bi + z_im[..., None] * br
    bu_re = jnp.einsum('blgh,gph->lbgp', ug, bb_re)
    bu_im = jnp.einsum('blgh,gph->lbgp', ug, bb_im)
    a_seq_re = jnp.broadcast_to(ab_re[None], (seq_len, S5_GROUPS, S5_STATE))
    a_seq_im = jnp.broadcast_to(ab_im[None], (seq_len, S5_GROUPS, S5_STATE))
    _, _, st_re, st_im = lax.associative_scan(_complex_scan_combine, (a_seq_re, a_seq_im, bu_re, bu_im), axis=0)
    y = (jnp.einsum('lbgp,ghp->blgh', st_re, c_re.astype(f32))
         - jnp.einsum('lbgp,ghp->blgh', st_im, c_im.astype(f32)))
    y = y.reshape(b_sz, seq_len, D_S5) + d_skip.astype(f32) * uf
    y = jax.nn.gelu(y)
    y = y * jax.nn.sigmoid(y @ w_glu.astype(f32) + b_glu.astype(f32))
    return rmsnorm(y, gain)


def conv_ffn(h, w_gate, w_up, conv_w, conv_b, w_down):
    a = h @ w_gate
    seq_len = a.shape[1]
    ap = jnp.pad(a, ((0, 0), (CONV_W - 1, 0), (0, 0)))
    conv = conv_b
    for j in range(CONV_W):
        conv = conv + conv_w[j] * ap[:, j:j + seq_len]
    return (jax.nn.silu(conv) * (h @ w_up)) @ w_down


def setup_inputs(seed: int = 0) -> dict:
    key = jax.random.key(seed)
    ks = jax.random.split(key, 32)
    f32 = jnp.float32

    def nrm(k, shape, s):
        return s * jax.random.normal(k, shape, f32)

    lam_im0 = jnp.pi * jnp.arange(S5_STATE, dtype=f32)
    return {
        "x": nrm(ks[0], (BATCH, SEQ, D_MODEL), 1.0),
        "meta_tokens": nrm(ks[1], (N_META, D_MODEL), 1.0),
        "lb_logits": nrm(ks[2], (DEPTH, D_HG), 0.1),
        "norm_mix": 1.0 + nrm(ks[3], (DEPTH, D_MODEL), 0.01),
        "w_in": nrm(ks[4], (DEPTH, D_MODEL, D_IN), D_MODEL ** -0.5),
        "hg_norm": 1.0 + nrm(ks[5], (DEPTH, D_HG), 0.01),
        "s5_lambda_re": -0.5 + nrm(ks[6], (DEPTH, S5_GROUPS, S5_STATE), 0.01),
        "s5_lambda_im": lam_im0 + nrm(ks[7], (DEPTH, S5_GROUPS, S5_STATE), 0.01),
        "s5_log_step": jax.random.uniform(ks[8], (DEPTH, S5_GROUPS), f32, math.log(DT_MIN), math.log(DT_MAX)),
        "s5_b_re": nrm(ks[9], (DEPTH, S5_GROUPS, S5_STATE, S5_GROUP), (2 * S5_GROUP) ** -0.5),
        "s5_b_im": nrm(ks[10], (DEPTH, S5_GROUPS, S5_STATE, S5_GROUP), (2 * S5_GROUP) ** -0.5),
        "s5_c_re": nrm(ks[11], (DEPTH, S5_GROUPS, S5_GROUP, S5_STATE), S5_STATE ** -0.5),
        "s5_c_im": nrm(ks[12], (DEPTH, S5_GROUPS, S5_GROUP, S5_STATE), S5_STATE ** -0.5),
        "s5_d": nrm(ks[13], (DEPTH, D_S5), 0.5),
        "w_glu": nrm(ks[14], (DEPTH, D_S5, D_S5), D_S5 ** -0.5),
        "b_glu": nrm(ks[15], (DEPTH, D_S5), 0.01),
        "s5_norm": 1.0 + nrm(ks[16], (DEPTH, D_S5), 0.01),
        "w_out": nrm(ks[17], (DEPTH, D_HG + D_S5, D_MODEL), (D_HG + D_S5) ** -0.5),
        "norm_ffn": 1.0 + nrm(ks[18], (DEPTH, D_MODEL), 0.01),
        "w_ffn_gate": nrm(ks[19], (DEPTH, D_MODEL, D_FF), D_MODEL ** -0.5),
        "w_ffn_up": nrm(ks[20], (DEPTH, D_MODEL, D_FF), D_MODEL ** -0.5),
        "ffn_conv_w": nrm(ks[21], (DEPTH, CONV_W, D_FF), CONV_W ** -0.5),
        "ffn_conv_b": nrm(ks[22], (DEPTH, D_FF), 0.01),
        "w_ffn_down": nrm(ks[23], (DEPTH, D_FF, D_MODEL), D_FF ** -0.5),
        "final_norm": 1.0 + nrm(ks[24], (D_MODEL,), 0.01),
    }


def reference(x, meta_tokens, lb_logits, norm_mix, w_in, hg_norm, s5_lambda_re, s5_lambda_im,
              s5_log_step, s5_b_re, s5_b_im, s5_c_re, s5_c_im, s5_d, w_glu, b_glu, s5_norm,
              w_out, norm_ffn, w_ffn_gate, w_ffn_up, ffn_conv_w, ffn_conv_b, w_ffn_down, final_norm):
    b_sz = x.shape[0]
    meta = jnp.broadcast_to(meta_tokens.astype(x.dtype)[None], (b_sz, N_META, D_MODEL))
    h = jnp.concatenate([meta, x], axis=1)
    sm = jax.nn.softmax(lb_logits.astype(jnp.float32), axis=0)
    lb_all = jnp.cumsum(sm, axis=0) - sm[0:1]
    for l in range(DEPTH):
        xn = rmsnorm(h, norm_mix[l])
        proj = xn @ w_in[l]
        q, f_logit, i_in, g_out, u = jnp.split(proj, [D_HG, 2 * D_HG, 3 * D_HG, 4 * D_HG], axis=-1)
        o_hg = hgrn2_mixer(q, f_logit, i_in, g_out, lb_all[l], hg_norm[l])
        o_s5 = s5_mixer(u, s5_lambda_re[l], s5_lambda_im[l], s5_log_step[l], s5_b_re[l], s5_b_im[l],
                        s5_c_re[l], s5_c_im[l], s5_d[l], w_glu[l], b_glu[l], s5_norm[l])
        mix = jnp.concatenate([o_hg, o_s5.astype(jnp.float32)], axis=-1).astype(h.dtype)
        h = h + mix @ w_out[l]
        h = h + conv_ffn(rmsnorm(h, norm_ffn[l]), w_ffn_gate[l], w_ffn_up[l], ffn_conv_w[l],
                         ffn_conv_b[l], w_ffn_down[l])
    return rmsnorm(h[:, N_META:], final_norm)
```

```cpp
#include <hip/hip_runtime.h>
#include <hip/hip_cooperative_groups.h>
#include <cstdio>
#include <cstdint>
namespace cg = cooperative_groups;
namespace pg8 {
#define PG8_LAS __attribute__((address_space(3)))
typedef unsigned short bf16_t;
typedef short bf16x8 __attribute__((ext_vector_type(8)));
typedef float f32x4 __attribute__((ext_vector_type(4)));
typedef unsigned u32x4 __attribute__((ext_vector_type(4)));
constexpr int BM = 256, BK = 64, HALF = 128, HTB = HALF * BK * 2  , STAGE_BYTES = 8 * HTB, NXCD = 8, WGM = 8;

__host__ __device__ __forceinline__ int lds_byte(int r, int c) { const int st = (r >> 4) * 2 + (c >> 5), rr = r & 15, cc = c & 31, ob = rr * 64 + cc * 2; return st * 1024 + (ob ^ (((ob >> 9) & 1) << 5)); }
__host__ __device__ __forceinline__ void stage_rc(int b, int& R, int& C) { const int st = b / 1024, sb = b % 1024, swz = sb ^ (((sb >> 9) & 1) << 5); R = (st >> 1) * 16 + swz / 64; C = (st & 1) * 32 + (swz % 64) / 2; }
__host__ __device__ __forceinline__ int perm32(int rho) { const int n = rho >> 4, i = rho & 15; return 8 * (i >> 2) + 4 * n + (i & 3); }

struct Unit { int pm, pn; };
struct Gemm { const bf16_t* A; const bf16_t* Bt; int M, N, K; };

struct StaticOrder {
    int nM, nN, nwg, G, c;
    __host__ __device__ void init(int M, int N, int G_, int c_) { nM = M / BM; nN = N / BM; nwg = nM * nN; G = G_; c = c_; }
    __host__ __device__ bool next(int i, Unit& u) const {
        const long L = (long)i * G + c; if (L >= nwg) return false;
        int wgid = (int)L; { const int q = nwg / NXCD, r = nwg % NXCD, xcd = wgid % NXCD, off = wgid / NXCD; wgid = (xcd < r ? xcd * (q + 1) : r * (q + 1) + (xcd - r) * q) + off; }
        const int nig = WGM * nN, gid = wgid / nig, fm = gid * WGM, gsz = (nM - fm) < WGM ? (nM - fm) : WGM;
        u.pm = fm + ((wgid % nig) % gsz); u.pn = (wgid % nig) / gsz; return true;
    }
    __device__ __forceinline__ void a_ready(const Unit&) const {}
    __device__ __forceinline__ void done(const Unit&) const {}
};

__device__ __forceinline__ unsigned cvt_pk_bf16(float lo, float hi) { unsigned r; asm volatile("v_cvt_pk_bf16_f32 %0, %1, %2" : "=v"(r) : "v"(lo), "v"(hi)); return r; }
__device__ __forceinline__ float bf_lo(unsigned w) { return __uint_as_float(w << 16); }
__device__ __forceinline__ float bf_hi(unsigned w) { return __uint_as_float(w & 0xffff0000u); }
__device__ __forceinline__ float sigmoid_f(float x) { return __builtin_amdgcn_rcpf(1.0f + __expf(-x)); }
__device__ __forceinline__ float silu_f(float x) { return x * sigmoid_f(x); }
constexpr int MMAIN_ROWS = 32768;
constexpr float NORM_EPS = 1e-6f;

struct EpiIn {
    static constexpr bool PERM = true, AFTER_DRAIN = false;
    const float* rs; const float* lb;
    bf16_t* Q; bf16_t* Kb; float* LF; bf16_t* V; bf16_t* GS; bf16_t* U;
    static __device__ __forceinline__ void fgate(float z, float lbv, float& kk, float& lf) {
        z = fminf(fmaxf(z, -30.f), 30.f); const float e = __expf(-z), sg = __builtin_amdgcn_rcpf(1.0f + e);
        const float f = lbv + (1.0f - lbv) * sg; lf = __logf(fmaxf(f, 1e-6f)); kk = (1.0f - lbv) * (e * sg); }
    __device__ __forceinline__ void operator()(const f32x4 (&acc)[2][2][4][2], const Unit& u, int wr, int wc, int fr, int fq) const {
        const int seg = u.pn >> 2, colt = (u.pn & 3) * BM;
        const int row0 = u.pm * BM + wr * 64 + fr, col0 = colt + wc * 32 + 8 * fq;
        bf16_t* dst = seg == 0 ? Q : (seg == 1 ? Kb : (seg == 2 ? V : (seg == 3 ? GS : U)));
#pragma unroll
        for (int ai = 0; ai < 2; ++ai)
#pragma unroll
            for (int m = 0; m < 4; ++m) {
                const int row = row0 + ai * HALF + m * 16;
                const float rstd = rsqrtf(rs[row] * (1.0f / 2048.0f) + NORM_EPS);
#pragma unroll
                for (int bj = 0; bj < 2; ++bj) {
                    const int c = col0 + bj * HALF; const size_t off = (size_t)row * 1024 + c;
                    f32x4 v0 = acc[ai][bj][m][0] * rstd, v1 = acc[ai][bj][m][1] * rstd;
                    if (seg == 1) {
                        const f32x4 l0 = *(const f32x4*)(lb + c), l1 = *(const f32x4*)(lb + c + 4);
                        f32x4 k0, k1, f0, f1; float tk, tf;
#define FG(vv, ll, kk, ff, i) fgate(vv[i], ll[i], tk, tf); kk[i] = tk; ff[i] = tf;
                        FG(v0, l0, k0, f0, 0) FG(v0, l0, k0, f0, 1) FG(v0, l0, k0, f0, 2) FG(v0, l0, k0, f0, 3)
                        FG(v1, l1, k1, f1, 0) FG(v1, l1, k1, f1, 1) FG(v1, l1, k1, f1, 2) FG(v1, l1, k1, f1, 3)
#undef FG
                        *(f32x4*)(LF + off) = f0; *(f32x4*)(LF + off + 4) = f1;
                        v0 = k0; v1 = k1;
                    } else if (seg == 0 || seg == 3) {
                        v0 = (f32x4){silu_f(v0[0]), silu_f(v0[1]), silu_f(v0[2]), silu_f(v0[3])}; v1 = (f32x4){silu_f(v1[0]), silu_f(v1[1]), silu_f(v1[2]), silu_f(v1[3])};
                    }
                    u32x4 w; w.x = cvt_pk_bf16(v0[0], v0[1]); w.y = cvt_pk_bf16(v0[2], v0[3]); w.z = cvt_pk_bf16(v1[0], v1[1]); w.w = cvt_pk_bf16(v1[2], v1[3]);
                    *(u32x4*)(dst + off) = w;
                }
            }
    }
};

struct EpiGlu {
    static constexpr bool PERM = true, AFTER_DRAIN = false;
    const bf16_t* Y; const float* bias; bf16_t* MIX; float* rs5;
    __device__ __forceinline__ void operator()(const f32x4 (&acc)[2][2][4][2], const Unit& u, int wr, int wc, int fr, int fq) const {
        const int row0 = u.pm * BM + wr * 64 + fr, col0 = u.pn * BM + wc * 32 + 8 * fq;
#pragma unroll
        for (int ai = 0; ai < 2; ++ai)
#pragma unroll
            for (int m = 0; m < 4; ++m) {
                const int row = row0 + ai * HALF + m * 16; float ss = 0.f;
#pragma unroll
                for (int bj = 0; bj < 2; ++bj) {
                    const int c = col0 + bj * HALF;
                    const f32x4 b0 = *(const f32x4*)(bias + c), b1 = *(const f32x4*)(bias + c + 4);
                    const u32x4 yw = *(const u32x4*)(Y + (size_t)row * 1024 + c);
                    float y[8] = {bf_lo(yw.x), bf_hi(yw.x), bf_lo(yw.y), bf_hi(yw.y), bf_lo(yw.z), bf_hi(yw.z), bf_lo(yw.w), bf_hi(yw.w)};
                    float o[8];
#pragma unroll
                    for (int j = 0; j < 8; ++j) { const float z = (j < 4 ? acc[ai][bj][m][0][j] + b0[j] : acc[ai][bj][m][1][j - 4] + b1[j - 4]); o[j] = y[j] * sigmoid_f(z); ss += o[j] * o[j]; }
                    u32x4 w; w.x = cvt_pk_bf16(o[0], o[1]); w.y = cvt_pk_bf16(o[2], o[3]); w.z = cvt_pk_bf16(o[4], o[5]); w.w = cvt_pk_bf16(o[6], o[7]);
                    *(u32x4*)(MIX + (size_t)row * 2048 + 1024 + c) = w;
                }
                ss += __shfl_xor(ss, 16); ss += __shfl_xor(ss, 32);
                if (fq == 0) atomicAdd(rs5 + row, ss);
            }
    }
};

struct EpiRes {
    static constexpr bool PERM = false, AFTER_DRAIN = false;
    const float* hin_main; float* hout_main; float* hmeta; bf16_t* HB; float* rsn;
    __device__ __forceinline__ void operator()(const f32x4 (&acc)[2][2][4][2], const Unit& u, int wr, int wc, int fr, int fq) const {
        const int rl0 = wr * 64 + fr, col0 = u.pn * BM + wc * 32 + 4 * fq;
        const bool meta = (u.pm * BM >= MMAIN_ROWS);
        const float* hin = meta ? hmeta : hin_main + (size_t)u.pm * BM * 2048;
        float* hout = meta ? hmeta : hout_main + (size_t)u.pm * BM * 2048;
#pragma unroll
        for (int ai = 0; ai < 2; ++ai)
#pragma unroll
            for (int m = 0; m < 4; ++m) {
                const int rl = rl0 + ai * HALF + m * 16, row = u.pm * BM + rl; float ss = 0.f;
#pragma unroll
                for (int bj = 0; bj < 2; ++bj)
#pragma unroll
                    for (int n = 0; n < 2; ++n) {
                        const int c = col0 + bj * HALF + n * 16;
                        const f32x4 hv = *(const f32x4*)(hin + (size_t)rl * 2048 + c);
                        const f32x4 o = hv + acc[ai][bj][m][n];
                        *(f32x4*)(hout + (size_t)rl * 2048 + c) = o;
                        ss += (o[0] * o[0] + o[1] * o[1]) + (o[2] * o[2] + o[3] * o[3]);
                        typedef unsigned u32x2 __attribute__((ext_vector_type(2)));
                        u32x2 w; w.x = cvt_pk_bf16(o[0], o[1]); w.y = cvt_pk_bf16(o[2], o[3]);
                        *(u32x2*)(HB + (size_t)row * 2048 + c) = w;
                    }
                ss += __shfl_xor(ss, 16); ss += __shfl_xor(ss, 32);
                if (fq == 0) atomicAdd(rsn + row, ss);
                asm volatile("" ::: "memory");
            }
    }
};

struct EpiGU {
    static constexpr bool PERM = true, AFTER_DRAIN = false;
    const float* rs; bf16_t* Hd; const float* cw; const float* cb; float* sideA; float* sideU; float* metaA;
    __device__ __forceinline__ void operator()(const f32x4 (&acc)[2][2][4][2], const Unit& u, int wr, int wc, int fr, int fq) const {
        const int lane = threadIdx.x & 63;
        const int f0 = u.pn * HALF + wc * 32 + 8 * fq;
        const int idx1 = (lane & 48) | ((fr - 1) & 15), idx2 = (lane & 48) | ((fr - 2) & 15);
#pragma unroll
        for (int ai = 0; ai < 2; ++ai) {
            const int seg = u.pm * 4 + ai * 2 + wr, rowb = u.pm * BM + ai * HALF + wr * 64 + fr;
            float rstd[4];
#pragma unroll
            for (int m = 0; m < 4; ++m) rstd[m] = rsqrtf(rs[rowb + m * 16] * (1.0f / 2048.0f) + NORM_EPS);
            unsigned pk[4][2][2];
#pragma unroll
            for (int n = 0; n < 2; ++n) {
                const int f = f0 + 4 * n;
                const f32x4 w0 = *(const f32x4*)(cw + f), w1 = *(const f32x4*)(cw + 5632 + f), w2 = *(const f32x4*)(cw + 2 * 5632 + f), bb = *(const f32x4*)(cb + f);
                f32x4 g[4], up[4];
#pragma unroll
                for (int m = 0; m < 4; ++m) { g[m] = acc[ai][0][m][n] * rstd[m]; up[m] = acc[ai][1][m][n] * rstd[m]; }
                if (fr < 2) { *(f32x4*)(sideA + (size_t)(seg * 4 + fr) * 5632 + f) = g[0]; *(f32x4*)(sideU + (size_t)(seg * 2 + fr) * 5632 + f) = up[0]; }
                if (fr >= 14) { *(f32x4*)(sideA + (size_t)(seg * 4 + 2 + fr - 14) * 5632 + f) = g[3];
                    if (u.pm * BM >= MMAIN_ROWS && ai == 0 && wr == 0) *(f32x4*)(metaA + (size_t)(fr - 14) * 5632 + f) = g[0]; }
#pragma unroll
                for (int m = 0; m < 4; ++m) {
                    float hv[4];
#pragma unroll
                    for (int j = 0; j < 4; ++j) {
                        const float s1 = (m > 0 && fr == 15) ? g[m > 0 ? m - 1 : 0][j] : g[m][j];
                        const float s2 = (m > 0 && fr >= 14) ? g[m > 0 ? m - 1 : 0][j] : g[m][j];
                        const float p1 = __shfl(s1, idx1), p2 = __shfl(s2, idx2);
                        const float cv = bb[j] + w0[j] * p2 + w1[j] * p1 + w2[j] * g[m][j];
                        hv[j] = silu_f(cv) * up[m][j];
                    }
                    pk[m][n][0] = cvt_pk_bf16(hv[0], hv[1]); pk[m][n][1] = cvt_pk_bf16(hv[2], hv[3]);
                }
            }
#pragma unroll
            for (int m = 0; m < 4; ++m) { u32x4 w; w.x = pk[m][0][0]; w.y = pk[m][0][1]; w.z = pk[m][1][0]; w.w = pk[m][1][1];
                *(u32x4*)(Hd + (size_t)(rowb + m * 16) * 5632 + f0) = w; }
        }
    }
};

template <class Epi, class Sched, bool ALIGN_EPI = false, bool SP2 = false>
__device__ __forceinline__ void gemm_phase(PG8_LAS unsigned char* lds, const Gemm g, const Sched& S, const Epi& E) {
    int tid_ = threadIdx.x; asm volatile("" : "+v"(tid_));
    const int tid = tid_, wid = __builtin_amdgcn_readfirstlane(tid >> 6), lane = tid & 63, wr = wid >> 2, wc = wid & 3, fr = lane & 15, fq = lane >> 4;
    const int K = g.K, nt = K / BK;
    unsigned voffA[2], voffB[2];
#pragma unroll
    for (int i = 0; i < 2; ++i) { int R, C; stage_rc(tid * 16 + i * 8192, R, C); const int Rb = Epi::PERM ? ((R & ~31) + perm32(R & 31)) : R;
        voffA[i] = (unsigned)(R * K + C) * 2u; voffB[i] = (unsigned)(Rb * K + C) * 2u; }
    const size_t kstep = (size_t)(BK * 2);
    const size_t hstep = (size_t)HALF * K * 2;
    const size_t tstep = 2 * hstep;
    const unsigned ldsw = (unsigned)wid * 1024u;
    const int aoff = lds_byte(wr * 64 + fr, fq * 8), boff = lds_byte(wc * 32 + fr, fq * 8);
#define PG8_SA(b, h) (((b) * 2 + (h)) * HTB)
#define PG8_SB(b, h) ((4 + (b) * 2 + (h)) * HTB)
#define PG8_STAGE(bufoff, gbase, voff) do { _Pragma("unroll") for (int _i = 0; _i < 2; ++_i) \
        __builtin_amdgcn_global_load_lds((const unsigned*)((const char*)(gbase) + (voff)[_i]), (PG8_LAS unsigned*)(lds + (bufoff) + ldsw + _i * 8192), 16, 0, 0); } while (0)
#define PG8_LDA(dst, b, h) do { _Pragma("unroll") for (int m = 0; m < 4; ++m) _Pragma("unroll") for (int k = 0; k < 2; ++k) dst[m][k] = *(const PG8_LAS bf16x8*)(lds + PG8_SA(b, h) + aoff + m * 2048 + k * 1024); } while (0)
#define PG8_LDB(dst, b, h) do { _Pragma("unroll") for (int n = 0; n < 2; ++n) _Pragma("unroll") for (int k = 0; k < 2; ++k) dst[n][k] = *(const PG8_LAS bf16x8*)(lds + PG8_SB(b, h) + boff + n * 2048 + k * 1024); } while (0)
#define PG8_MMA(ai, bj, At, Bt) do { __builtin_amdgcn_s_setprio(1); _Pragma("unroll") for (int m = 0; m < 4; ++m) _Pragma("unroll") for (int n = 0; n < 2; ++n) _Pragma("unroll") for (int k = 0; k < 2; ++k) \
        acc[ai][bj][m][n] = __builtin_amdgcn_mfma_f32_16x16x32_bf16(Bt[n][k], At[m][k], acc[ai][bj][m][n], 0, 0, 0); __builtin_amdgcn_s_setprio(0); } while (0)
#define PG8_WAIT_V(n) asm volatile("s_waitcnt vmcnt(" #n ")" ::: "memory")
#define PG8_WAIT_L(n) asm volatile("s_waitcnt lgkmcnt(" #n ")" ::: "memory")
#define PG8_BAR __builtin_amdgcn_s_barrier()
#define PG8_SCHED __builtin_amdgcn_sched_barrier(0)
    Unit cur, nxt; int ui = 0;
    if (!S.next(0, cur)) return;
    f32x4 acc[2][2][4][2];
#pragma unroll
    for (int a = 0; a < 2; ++a)
#pragma unroll
        for (int b = 0; b < 2; ++b)
#pragma unroll
            for (int m = 0; m < 4; ++m)
#pragma unroll
                for (int n = 0; n < 2; ++n) acc[a][b][m][n] = (f32x4){0.f, 0.f, 0.f, 0.f};
    bf16x8 At[4][2], B0[2][2], B1[2][2];
    const char* cA = (const char*)g.A + (size_t)cur.pm * tstep; const char* cB = (const char*)g.Bt + (size_t)cur.pn * tstep;
    S.a_ready(cur);
    if constexpr (SP2) {
        PG8_STAGE(PG8_SB(0, 0), cB, voffB); PG8_STAGE(PG8_SB(0, 1), cB + hstep, voffB); PG8_STAGE(PG8_SA(0, 0), cA, voffA); PG8_STAGE(PG8_SA(0, 1), cA + hstep, voffA);
        if (wr == 1) PG8_BAR;
        PG8_WAIT_V(2); PG8_BAR;
        PG8_STAGE(PG8_SB(1, 0), cB + kstep, voffB); PG8_STAGE(PG8_SA(1, 0), cA + kstep, voffA); PG8_STAGE(PG8_SB(1, 1), cB + hstep + kstep, voffB);
        PG8_WAIT_V(6); PG8_BAR;
    } else {
        PG8_STAGE(PG8_SB(0, 0), cB, voffB); PG8_STAGE(PG8_SA(0, 0), cA, voffA); PG8_STAGE(PG8_SB(0, 1), cB + hstep, voffB); PG8_STAGE(PG8_SA(0, 1), cA + hstep, voffA);
        if (wr == 1) PG8_BAR;
        PG8_WAIT_V(4); PG8_BAR;
        PG8_STAGE(PG8_SB(1, 0), cB + kstep, voffB); PG8_STAGE(PG8_SA(1, 0), cA + kstep, voffA); PG8_STAGE(PG8_SB(1, 1), cB + hstep + kstep, voffB);
        PG8_WAIT_V(6); PG8_BAR;
    }
    for (;;) {
        const bool has_next = S.next(ui + 1, nxt);
        const char* nA = has_next ? (const char*)g.A + (size_t)nxt.pm * tstep : cA; const char* nB = has_next ? (const char*)g.Bt + (size_t)nxt.pn * tstep : cB;
        for (int t = 0; t < nt; t += 2) {
            const bool last = (t == nt - 2);
            const char* a1 = cA + (size_t)(t + 1) * kstep;
            const char* a2 = last ? nA : cA + (size_t)(t + 2) * kstep; const char* b2 = last ? nB : cB + (size_t)(t + 2) * kstep;
            const char* a3 = a2 + kstep; const char* b3 = b2 + kstep;
            if (last && has_next) S.a_ready(nxt);
            if constexpr (SP2) {
            PG8_LDB(B0, 0, 0); PG8_LDB(B1, 0, 1); PG8_SCHED; PG8_LDA(At, 0, 0); PG8_STAGE(PG8_SA(1, 1), a1 + hstep, voffA);
            PG8_WAIT_V(8); PG8_WAIT_L(0); PG8_BAR; PG8_MMA(0, 0, At, B0); PG8_MMA(0, 1, At, B1); PG8_BAR; PG8_SCHED;
            PG8_LDA(At, 0, 1); PG8_STAGE(PG8_SB(0, 0), b2, voffB); PG8_STAGE(PG8_SB(0, 1), b2 + hstep, voffB); PG8_STAGE(PG8_SA(0, 0), a2, voffA);
            PG8_WAIT_V(8); PG8_WAIT_L(0); PG8_BAR; PG8_MMA(1, 0, At, B0); PG8_MMA(1, 1, At, B1); PG8_BAR; PG8_SCHED;
            PG8_LDB(B0, 1, 0); PG8_LDB(B1, 1, 1); PG8_SCHED; PG8_LDA(At, 1, 0); PG8_STAGE(PG8_SA(0, 1), a2 + hstep, voffA);
            PG8_WAIT_V(8); PG8_WAIT_L(0); PG8_BAR; PG8_MMA(0, 0, At, B0); PG8_MMA(0, 1, At, B1); PG8_BAR; PG8_SCHED;
            PG8_LDA(At, 1, 1); PG8_STAGE(PG8_SB(1, 0), b3, voffB); PG8_STAGE(PG8_SB(1, 1), b3 + hstep, voffB); PG8_STAGE(PG8_SA(1, 0), a3, voffA);
            PG8_WAIT_V(8); PG8_WAIT_L(0); PG8_BAR; PG8_MMA(1, 0, At, B0); PG8_MMA(1, 1, At, B1); PG8_BAR; PG8_SCHED;
            } else {
            PG8_LDB(B0, 0, 0); PG8_SCHED; PG8_LDA(At, 0, 0); PG8_STAGE(PG8_SA(1, 1), a1 + hstep, voffA);
            PG8_WAIT_L(8); PG8_BAR; PG8_WAIT_L(0); PG8_MMA(0, 0, At, B0); PG8_BAR; PG8_SCHED;
            PG8_LDB(B1, 0, 1); PG8_STAGE(PG8_SB(0, 0), b2, voffB);
            PG8_BAR; PG8_WAIT_L(0); PG8_MMA(0, 1, At, B1); PG8_BAR;
            PG8_LDA(At, 0, 1); PG8_STAGE(PG8_SA(0, 0), a2, voffA);
            PG8_BAR; PG8_WAIT_L(0); PG8_MMA(1, 0, At, B0); PG8_BAR; PG8_SCHED;
            PG8_STAGE(PG8_SB(0, 1), b2 + hstep, voffB);
            PG8_WAIT_V(6); PG8_BAR; PG8_MMA(1, 1, At, B1); PG8_BAR;
            PG8_LDB(B0, 1, 0); PG8_SCHED; PG8_LDA(At, 1, 0); PG8_STAGE(PG8_SA(0, 1), a2 + hstep, voffA);
            PG8_WAIT_L(8); PG8_BAR; PG8_WAIT_L(0); PG8_MMA(0, 0, At, B0); PG8_BAR; PG8_SCHED;
            PG8_LDB(B1, 1, 1); PG8_STAGE(PG8_SB(1, 0), b3, voffB);
            PG8_BAR; PG8_WAIT_L(0); PG8_MMA(0, 1, At, B1); PG8_BAR;
            PG8_LDA(At, 1, 1); PG8_STAGE(PG8_SA(1, 0), a3, voffA);
            PG8_BAR; PG8_WAIT_L(0); PG8_MMA(1, 0, At, B0); PG8_BAR; PG8_SCHED;
            PG8_STAGE(PG8_SB(1, 1), b3 + hstep, voffB);
            PG8_WAIT_V(6); PG8_BAR; PG8_MMA(1, 1, At, B1); PG8_BAR;
            }
        }
        if constexpr (ALIGN_EPI) { if (wr == 0) PG8_BAR; }
        if constexpr (!Epi::AFTER_DRAIN) { E(acc, cur, wr, wc, fr, fq); S.done(cur); }
        if (!has_next) break;
#pragma unroll
        for (int a = 0; a < 2; ++a)
#pragma unroll
            for (int b = 0; b < 2; ++b)
#pragma unroll
                for (int m = 0; m < 4; ++m)
#pragma unroll
                    for (int n = 0; n < 2; ++n) acc[a][b][m][n] = (f32x4){0.f, 0.f, 0.f, 0.f};
        cur = nxt; cA = nA; cB = nB; ++ui;
        if constexpr (ALIGN_EPI) { if (wr == 1) PG8_BAR; }
    }
    PG8_WAIT_V(0);
    if constexpr (!ALIGN_EPI) { if (wr == 0) PG8_BAR; }
    PG8_BAR;
    if constexpr (Epi::AFTER_DRAIN) { E.fused(acc, cur, wr, wc, fr, fq, lds, wid, lane); S.done(cur); }
#undef PG8_SA
#undef PG8_SB
#undef PG8_STAGE
#undef PG8_LDA
#undef PG8_LDB
#undef PG8_MMA
#undef PG8_WAIT_V
#undef PG8_WAIT_L
#undef PG8_BAR
#undef PG8_SCHED
}
}
#define LAS __attribute__((address_space(3)))
typedef unsigned short bf16;
typedef float f32x4 __attribute__((ext_vector_type(4)));
typedef unsigned v4u __attribute__((ext_vector_type(4)));
typedef unsigned v2u __attribute__((ext_vector_type(2)));
typedef short bf16x8 __attribute__((ext_vector_type(8)));
constexpr int DM = 2048, SEQ = 2048, BATCH = 16, NMETA = 16, DEPTH = 2;
constexpr int DHG = 1024, DS5 = 1024, DIN = 5120, DFF = 5632;
constexpr int MMAIN = BATCH * SEQ;
constexpr int META0 = MMAIN;
constexpr int MPAD = MMAIN + 256;
constexpr int NSEGS = MPAD / 64;
constexpr float EPS = 1e-6f;
constexpr int NWAVES = 8, NTHREADS = 512;
constexpr int LDS_BYTES = 147456;

constexpr size_t MiB = 1u << 20;
constexpr size_t WS_CTL = 0, CTL_ZERO_BYTES = 2 * MiB;
constexpr size_t RS_STRIDE = MPAD;
constexpr size_t WS_S5A = 2 * MiB;
constexpr size_t WS_S5B = 2 * MiB + 128 * 1024;
constexpr size_t WS_LB = 3 * MiB + 512 * 1024;
constexpr size_t WS_HMETA = 4 * MiB;
constexpr size_t WS_METAA = 6 * MiB;
constexpr size_t WS_W = 8 * MiB, W_LAYER = 96 * MiB;
constexpr size_t W_IN = 0, W_GLU = 20 * MiB, W_OUT = 22 * MiB, W_GU = 30 * MiB, W_DN = 74 * MiB;
constexpr size_t WS_HB = 200 * MiB;
constexpr size_t WS_MIX = 329 * MiB;
constexpr size_t WS_SIDEA = WS_MIX, WS_SIDEU = WS_MIX + 48 * MiB;
constexpr size_t WS_R = 458 * MiB;
constexpr size_t PB = (size_t)MPAD * 1024 * 2;
constexpr size_t WS_Q = WS_R, WS_K = WS_R + PB, WS_V = WS_R + 2 * PB, WS_GS = WS_R + 3 * PB, WS_U = WS_R + 4 * PB, WS_LF = WS_R + 5 * PB;
constexpr size_t WS_HID = WS_R;
constexpr size_t WS_Y = WS_R + 7 * PB;
constexpr size_t WS_END = WS_R + 8 * PB;
static_assert((size_t)NSEGS * 4 * 5632 * 4 <= 48 * MiB && WS_SIDEU + (size_t)NSEGS * 2 * 5632 * 4 <= WS_R, "side buffers inside the mix region");
static_assert((size_t)MPAD * 5632 * 2 <= 7 * PB && WS_END <= 1024 * MiB, "workspace map");

__device__ __forceinline__ unsigned f2bf(float f) { unsigned u = __builtin_bit_cast(unsigned, f); return (u + 0x7fffu + ((u >> 16) & 1u)) >> 16; }
__device__ __forceinline__ unsigned pk2(float lo, float hi) { return f2bf(lo) | (f2bf(hi) << 16); }
__device__ __forceinline__ float bflo(unsigned w) { return __uint_as_float(w << 16); }
__device__ __forceinline__ float bfhi(unsigned w) { return __uint_as_float(w & 0xffff0000u); }
__device__ __forceinline__ float wave_sum(float v) {
#pragma unroll
    for (int o = 1; o < 64; o <<= 1) v += __shfl_xor(v, o);
    return v;
}
#define LDS_WAIT() asm volatile("s_waitcnt lgkmcnt(0)" ::: "memory")

struct Args { const float* in[25]; float* out; unsigned char* ws; int ph_lo, ph_hi; };

__device__ __forceinline__ void transpose_item(const float* W, int K, int N, bf16* WT, int drow0, const float* kscale, LAS float* scr, int k0, int n0, int lane) {
#pragma unroll 8
    for (int i = 0; i < 32; ++i) { const int kk = 2 * i + (lane >> 5); float w = W[(size_t)(k0 + kk) * N + n0 + (lane & 31)]; if (kscale) w *= kscale[k0 + kk]; scr[kk * 33 + (lane & 31)] = w; }
    LDS_WAIT(); asm volatile("" ::: "memory");
    const int c = lane & 7;
#pragma unroll
    for (int j = 0; j < 4; ++j) { const int n = (lane >> 3) + 8 * j; const LAS float* s = scr + (8 * c) * 33 + n;
        v4u o; o.x = pk2(s[0 * 33], s[1 * 33]); o.y = pk2(s[2 * 33], s[3 * 33]); o.z = pk2(s[4 * 33], s[5 * 33]); o.w = pk2(s[6 * 33], s[7 * 33]);
        *(v4u*)(WT + (size_t)(drow0 + n) * K + k0 + 8 * c) = o; }
    LDS_WAIT(); asm volatile("" ::: "memory");
}

__device__ __forceinline__ void p0_prologue(const Args& a, LAS unsigned char* lds) {
    int tid = threadIdx.x; asm volatile("" : "+v"(tid));
    const int lane = tid & 63, wave = tid >> 6;
    const int gw = blockIdx.x * NWAVES + wave, NGW = gridDim.x * NWAVES;
    unsigned char* ws = a.ws;
    LAS float* scr = (LAS float*)(lds + wave * 16384);
    constexpr int I_IN = 32 * 160, I_GLU = 16 * 32, I_OUT = 32 * 64, I_G = 32 * 176, I_DN = 88 * 64, PER_L = I_IN + I_GLU + I_OUT + 2 * I_G + I_DN;
    for (int it = gw; it < DEPTH * PER_L; it += NGW) {
        const int l = it / PER_L; int r = it % PER_L;
        unsigned char* wl = ws + WS_W + (size_t)l * W_LAYER;
        if (r < I_IN) { transpose_item(a.in[4] + (size_t)l * DM * DIN, DM, DIN, (bf16*)(wl + W_IN), 32 * (r % 160), a.in[3] + l * DM, scr, 64 * (r / 160), 32 * (r % 160), lane); continue; } r -= I_IN;
        if (r < I_GLU) { transpose_item(a.in[14] + (size_t)l * DS5 * DS5, DS5, DS5, (bf16*)(wl + W_GLU), 32 * (r % 32), nullptr, scr, 64 * (r / 32), 32 * (r % 32), lane); continue; } r -= I_GLU;
        if (r < I_OUT) { transpose_item(a.in[17] + (size_t)l * DM * DM, DM, DM, (bf16*)(wl + W_OUT), 32 * (r % 64), nullptr, scr, 64 * (r / 64), 32 * (r % 64), lane); continue; } r -= I_OUT;
        if (r < 2 * I_G) { const int up = r >= I_G; if (up) r -= I_G; const int n0 = 32 * (r % 176), drow0 = 256 * (n0 / 128) + (n0 % 128) + (up ? 128 : 0);
            transpose_item(a.in[up ? 20 : 19] + (size_t)l * DM * DFF, DM, DFF, (bf16*)(wl + W_GU), drow0, a.in[18] + l * DM, scr, 64 * (r / 176), n0, lane); continue; } r -= 2 * I_G;
        transpose_item(a.in[23] + (size_t)l * DFF * DM, DFF, DM, (bf16*)(wl + W_DN), 32 * (r % 64), nullptr, scr, 64 * (r / 64), 32 * (r % 64), lane);
    }
    float* rs0 = (float*)(ws + WS_CTL); bf16* HB = (bf16*)(ws + WS_HB); float* hmeta = (float*)(ws + WS_HMETA);
    for (int m = gw; m < MPAD; m += NGW) {
        const float* src = m < MMAIN ? a.in[0] + (size_t)m * DM : (m < MMAIN + NMETA ? a.in[1] + (size_t)(m - MMAIN) * DM : nullptr);
        f32x4 v[8]; float ss = 0.f;
#pragma unroll
        for (int j = 0; j < 8; ++j) { v[j] = src ? *(const f32x4*)(src + 4 * lane + 256 * j) : (f32x4){0.f, 0.f, 0.f, 0.f}; ss += (v[j][0] * v[j][0] + v[j][1] * v[j][1]) + (v[j][2] * v[j][2] + v[j][3] * v[j][3]); }
        ss = wave_sum(ss);
#pragma unroll
        for (int j = 0; j < 8; ++j) { v2u w; w.x = pk2(v[j][0], v[j][1]); w.y = pk2(v[j][2], v[j][3]); *(v2u*)(HB + (size_t)m * DM + 4 * lane + 256 * j) = w;
            if (m >= MMAIN) *(f32x4*)(hmeta + (size_t)(m - MMAIN) * DM + 4 * lane + 256 * j) = v[j]; }
        if (lane == 0) rs0[m] = ss;
    }
    const int gt = blockIdx.x * NTHREADS + tid, NGT = gridDim.x * NTHREADS;
    float* S5A = (float*)(ws + WS_S5A); float* S5B = (float*)(ws + WS_S5B); float* LB = (float*)(ws + WS_LB);
    for (int i = gt; i < DEPTH * 64 * 64; i += NGT) {
        const int lg = i >> 6;
        const float are = fminf(a.in[6][i], -1e-4f), aim = a.in[7][i], dt = expf(a.in[8][lg]);
        const float mag = expf(are * dt), abr = mag * cosf(aim * dt), abi = mag * sinf(aim * dt);
        const float den = are * are + aim * aim, xre = abr - 1.0f, xim = abi;
        const float zre = (xre * are + xim * aim) / den, zim = (xim * are - xre * aim) / den;
        S5A[2 * i] = abr; S5A[2 * i + 1] = abi;
        for (int h = 0; h < 16; ++h) { const float br = a.in[9][(size_t)i * 16 + h], bi = a.in[10][(size_t)i * 16 + h];
            S5B[((size_t)i * 16 + h) * 2] = zre * br - zim * bi; S5B[((size_t)i * 16 + h) * 2 + 1] = zre * bi + zim * br; }
    }
    for (int i = gt; i < DHG; i += NGT) {
        const float x0 = a.in[2][i], x1 = a.in[2][DHG + i], mx = fmaxf(x0, x1), e0 = expf(x0 - mx), e1 = expf(x1 - mx), s0 = e0 / (e0 + e1), s1 = e1 / (e0 + e1);
        LB[i] = s0 - s0; LB[DHG + i] = (s0 + s1) - s0;
    }
}

__device__ __forceinline__ void hgrn2_item(LAS unsigned char* lds, const int tid, int b, int h, const bf16* Q, const bf16* Kb, const float* LF, const bf16* V, const bf16* GS, bf16* MIX, const float* gain) {
    LAS float* qs = (LAS float*)lds; LAS float* ks = qs + 2048; LAS float* fs = ks + 2048; LAS float* vs = fs + 2048; LAS float* op = vs + 2048;
    const int e = tid & 127, dq = tid >> 7, st = tid >> 5, sd = (tid & 31) * 4;
    float S[32];
#pragma unroll
    for (int i = 0; i < 32; ++i) S[i] = 0.f;
    v2u rq, rk, rv; f32x4 rf;
    { const size_t o = (size_t)(META0 + st) * 1024 + h * 128 + sd; rq = *(const v2u*)(Q + o); rk = *(const v2u*)(Kb + o); rv = *(const v2u*)(V + o); rf = *(const f32x4*)(LF + o); }
    for (int c = 0; c <= 128; ++c) {
        const int row0 = c == 0 ? META0 : b * SEQ + 16 * (c - 1);
        { LAS float* p = qs + st * 128 + sd; p[0] = bflo(rq.x); p[1] = bfhi(rq.x); p[2] = bflo(rq.y); p[3] = bfhi(rq.y);
          p = ks + st * 128 + sd; p[0] = bflo(rk.x); p[1] = bfhi(rk.x); p[2] = bflo(rk.y); p[3] = bfhi(rk.y);
          p = vs + st * 128 + sd; p[0] = bflo(rv.x); p[1] = bfhi(rv.x); p[2] = bflo(rv.y); p[3] = bfhi(rv.y);
          p = fs + st * 128 + sd; p[0] = __expf(rf[0]); p[1] = __expf(rf[1]); p[2] = __expf(rf[2]); p[3] = __expf(rf[3]); }
        __syncthreads();
        if (c < 128) { const size_t o = (size_t)(b * SEQ + 16 * c + st) * 1024 + h * 128 + sd; rq = *(const v2u*)(Q + o); rk = *(const v2u*)(Kb + o); rv = *(const v2u*)(V + o); rf = *(const f32x4*)(LF + o); }
        for (int t = 0; t < 16; ++t) {
            const float ve = vs[t * 128 + e]; float acc = 0.f;
#pragma unroll
            for (int i4 = 0; i4 < 8; ++i4) {
                const f32x4 f = *(const LAS f32x4*)(fs + t * 128 + 32 * dq + 4 * i4), kk = *(const LAS f32x4*)(ks + t * 128 + 32 * dq + 4 * i4), qq = *(const LAS f32x4*)(qs + t * 128 + 32 * dq + 4 * i4);
#pragma unroll
                for (int j = 0; j < 4; ++j) { S[4 * i4 + j] = f[j] * S[4 * i4 + j] + kk[j] * ve; acc += qq[j] * S[4 * i4 + j]; }
            }
            op[(t * 4 + dq) * 128 + e] = acc;
        }
        __syncthreads();
        {
            f32x4 o = *(const LAS f32x4*)(op + (st * 4 + 0) * 128 + sd) + *(const LAS f32x4*)(op + (st * 4 + 1) * 128 + sd) + *(const LAS f32x4*)(op + (st * 4 + 2) * 128 + sd) + *(const LAS f32x4*)(op + (st * 4 + 3) * 128 + sd);
            float ss = (o[0] * o[0] + o[1] * o[1]) + (o[2] * o[2] + o[3] * o[3]);
#pragma unroll
            for (int x = 1; x < 32; x <<= 1) ss += __shfl_xor(ss, x);
            const float rstd = rsqrtf(ss * (1.0f / 128.0f) + EPS);
            const int row = row0 + st; const size_t go = (size_t)row * 1024 + h * 128 + sd;
            const v2u gw = *(const v2u*)(GS + go); const f32x4 gn = *(const f32x4*)(gain + h * 128 + sd);
            v2u w; w.x = pk2(o[0] * rstd * gn[0] * bflo(gw.x), o[1] * rstd * gn[1] * bfhi(gw.x)); w.y = pk2(o[2] * rstd * gn[2] * bflo(gw.y), o[3] * rstd * gn[3] * bfhi(gw.y));
            if (c > 0 || b == 0) *(v2u*)(MIX + (size_t)row * 2048 + h * 128 + sd) = w;
        }
    }
    __syncthreads();
}

__device__ __forceinline__ void s5_item(LAS unsigned char* ldsw, int b, int g, int lane, const bf16* UY, bf16* YO, const float* S5A, const float* S5B, const float* cre, const float* cim, const float* dsk) {
    LAS bf16* Xs = (LAS bf16*)ldsw;
    LAS float* Us = (LAS float*)(ldsw + 4352);
    const int p = lane, fr = lane & 15, fq = lane >> 4;
    const float ar = S5A[(g * 64 + p) * 2], ai = S5A[(g * 64 + p) * 2 + 1];
    float Bre[16], Bim[16];
#pragma unroll
    for (int h = 0; h < 16; ++h) { Bre[h] = S5B[((size_t)(g * 64 + p) * 16 + h) * 2]; Bim[h] = S5B[((size_t)(g * 64 + p) * 16 + h) * 2 + 1]; }
    bf16x8 cf[4];
#pragma unroll
    for (int ks = 0; ks < 4; ++ks)
#pragma unroll
        for (int j = 0; j < 8; ++j) { const int k = 32 * ks + 8 * fq + j; const float val = k < 64 ? cre[(size_t)(g * 16 + fr) * 64 + k] : -cim[(size_t)(g * 16 + fr) * 64 + (k - 64)]; cf[ks][j] = (short)f2bf(val); }
    const float dv = dsk[g * 16 + fr];
    float xr = 0.f, xi = 0.f;
    const int lt = (lane >> 1) & 15, lh = lane & 1;
    v4u ru = *(const v4u*)(UY + (size_t)(META0 + lt) * 1024 + g * 16 + 8 * lh);
    for (int c = 0; c <= 128; ++c) {
        const int row0 = c == 0 ? META0 : b * SEQ + 16 * (c - 1);
        if (lane < 32) { LAS float* q = Us + lt * 16 + 8 * lh; q[0] = bflo(ru.x); q[1] = bfhi(ru.x); q[2] = bflo(ru.y); q[3] = bfhi(ru.y); q[4] = bflo(ru.z); q[5] = bfhi(ru.z); q[6] = bflo(ru.w); q[7] = bfhi(ru.w); }
        LDS_WAIT(); asm volatile("" ::: "memory");
        if (c < 128) ru = *(const v4u*)(UY + (size_t)(b * SEQ + 16 * c + lt) * 1024 + g * 16 + 8 * lh);
#pragma unroll 4
        for (int t = 0; t < 16; ++t) {
            float bur = 0.f, bui = 0.f;
#pragma unroll
            for (int h4 = 0; h4 < 4; ++h4) { const f32x4 uu = *(const LAS f32x4*)(Us + t * 16 + 4 * h4);
#pragma unroll
                for (int j = 0; j < 4; ++j) { bur += Bre[4 * h4 + j] * uu[j]; bui += Bim[4 * h4 + j] * uu[j]; } }
            const float nxr = ar * xr - ai * xi + bur, nxi = ar * xi + ai * xr + bui; xr = nxr; xi = nxi;
            Xs[t * 136 + p] = (bf16)f2bf(xr); Xs[t * 136 + 64 + p] = (bf16)f2bf(xi);
        }
        LDS_WAIT(); asm volatile("" ::: "memory");
        f32x4 acc = {0.f, 0.f, 0.f, 0.f};
#pragma unroll
        for (int ks = 0; ks < 4; ++ks) { const bf16x8 af = *(const LAS bf16x8*)(Xs + fr * 136 + 32 * ks + 8 * fq); acc = __builtin_amdgcn_mfma_f32_16x16x32_bf16(af, cf[ks], acc, 0, 0, 0); }
#pragma unroll
        for (int r = 0; r < 4; ++r) { const int t = 4 * fq + r; const float uu = Us[t * 16 + fr]; float y = acc[r] + dv * uu;
            const float in = 1.5957691216f * (y + 0.044715f * y * y * y); y = y * __builtin_amdgcn_rcpf(1.0f + __expf(-in));
            if (c > 0 || b == 0) YO[(size_t)(row0 + t) * 1024 + g * 16 + fr] = (bf16)f2bf(y); }
        LDS_WAIT(); asm volatile("" ::: "memory");
    }
}
#ifndef ONE_LAUNCH
#define ONE_LAUNCH 0
#endif
#ifndef ONLY
#define ONLY -1
#endif
#define PH_ON(k) (ONLY == -1 || ONLY == (k))
constexpr int NPHASES = 18;

#define IN(k) (lo <= (k) && (k) < hi)
#define SEAM(k) do { if (IN(k) && IN((k) + 1)) cg::this_grid().sync(); } while (0)

template <int L> __device__ __forceinline__ void layer_phases(const Args& args, LAS unsigned char* lds, const int lo, const int hi) {
    constexpr int P = 1 + 8 * L;
    unsigned char* const ws = args.ws;
    const int G = gridDim.x;
    if (IN(P + 0) && PH_ON(0)) {
        unsigned char* wl = ws + WS_W + (size_t)L * W_LAYER; float* RS = (float*)(ws + WS_CTL);
        pg8::Gemm g{(const bf16*)(ws + WS_HB), (const bf16*)(wl + W_IN), MPAD, DIN, DM}; pg8::StaticOrder S; S.init(MPAD, DIN, G, (int)blockIdx.x);
        pg8::EpiIn E{RS + (2 * L) * RS_STRIDE, (const float*)(ws + WS_LB) + L * DHG, (bf16*)(ws + WS_Q), (bf16*)(ws + WS_K), (float*)(ws + WS_LF), (bf16*)(ws + WS_V), (bf16*)(ws + WS_GS), (bf16*)(ws + WS_U)};
        pg8::gemm_phase<pg8::EpiIn, pg8::StaticOrder, true, true>(lds, g, S, E);
    }
    SEAM(P + 0);
    if (IN(P + 1) && PH_ON(1)) {
        int tid = threadIdx.x; asm volatile("" : "+v"(tid));
        const int lane = tid & 63, wave = __builtin_amdgcn_readfirstlane(tid >> 6);
        for (int it = blockIdx.x; it < 256; it += G) {
            if (it < 128) hgrn2_item(lds, tid, it >> 3, it & 7, (const bf16*)(ws + WS_Q), (const bf16*)(ws + WS_K), (const float*)(ws + WS_LF), (const bf16*)(ws + WS_V), (const bf16*)(ws + WS_GS), (bf16*)(ws + WS_MIX), args.in[5] + L * DHG);
            else { const int idx = (it - 128) * 8 + wave;
                s5_item(lds + wave * 8192, idx >> 6, idx & 63, lane, (const bf16*)(ws + WS_U), (bf16*)(ws + WS_Y), (const float*)(ws + WS_S5A) + L * 64 * 64 * 2, (const float*)(ws + WS_S5B) + (size_t)L * 64 * 64 * 32,
                        args.in[11] + (size_t)L * 64 * 16 * 64, args.in[12] + (size_t)L * 64 * 16 * 64, args.in[13] + L * DS5);
                __syncthreads(); }
        }
    }
    SEAM(P + 1);
    if (IN(P + 2) && PH_ON(2)) {
        unsigned char* wl = ws + WS_W + (size_t)L * W_LAYER; float* RS = (float*)(ws + WS_CTL);
        pg8::Gemm g{(const bf16*)(ws + WS_Y), (const bf16*)(wl + W_GLU), MPAD, DS5, DS5}; pg8::StaticOrder S; S.init(MPAD, DS5, G, (int)blockIdx.x);
        pg8::EpiGlu E{(const bf16*)(ws + WS_Y), args.in[15] + L * DS5, (bf16*)(ws + WS_MIX), RS + (5 + L) * RS_STRIDE};
        pg8::gemm_phase<pg8::EpiGlu, pg8::StaticOrder, true, true>(lds, g, S, E);
    }
    SEAM(P + 2);
    if (IN(P + 3) && PH_ON(3)) {
        int tid = threadIdx.x; asm volatile("" : "+v"(tid));
        const int lane = tid & 63, wave = tid >> 6;
        const int gw = blockIdx.x * NWAVES + wave, NGW = G * NWAVES; const float* rs = (const float*)(ws + WS_CTL) + (5 + L) * RS_STRIDE; const float* gn = args.in[16] + L * DS5; bf16* MIX = (bf16*)(ws + WS_MIX);
        for (int m = gw; m < MPAD; m += NGW) {
            const float rstd = rsqrtf(rs[m] * (1.0f / 1024.0f) + EPS);
#pragma unroll
            for (int j = 0; j < 2; ++j) { bf16* p = MIX + (size_t)m * 2048 + 1024 + 8 * lane + 512 * j; const v4u w = *(const v4u*)p;
                const f32x4 g0 = *(const f32x4*)(gn + 8 * lane + 512 * j), g1 = *(const f32x4*)(gn + 8 * lane + 512 * j + 4);
                v4u o; o.x = pk2(bflo(w.x) * rstd * g0[0], bfhi(w.x) * rstd * g0[1]); o.y = pk2(bflo(w.y) * rstd * g0[2], bfhi(w.y) * rstd * g0[3]);
                o.z = pk2(bflo(w.z) * rstd * g1[0], bfhi(w.z) * rstd * g1[1]); o.w = pk2(bflo(w.w) * rstd * g1[2], bfhi(w.w) * rstd * g1[3]); *(v4u*)p = o; }
        }
    }
    SEAM(P + 3);
    if (IN(P + 4) && PH_ON(4)) {
        unsigned char* wl = ws + WS_W + (size_t)L * W_LAYER; float* RS = (float*)(ws + WS_CTL);
        pg8::Gemm g{(const bf16*)(ws + WS_MIX), (const bf16*)(wl + W_OUT), MPAD, DM, DM}; pg8::StaticOrder S; S.init(MPAD, DM, G, (int)blockIdx.x);
        pg8::EpiRes E{L == 0 ? args.in[0] : args.out, args.out, (float*)(ws + WS_HMETA), (bf16*)(ws + WS_HB), RS + (2 * L + 1) * RS_STRIDE};
        pg8::gemm_phase<pg8::EpiRes, pg8::StaticOrder, true, true>(lds, g, S, E);
    }
    SEAM(P + 4);
    if (IN(P + 5) && PH_ON(5)) {
        unsigned char* wl = ws + WS_W + (size_t)L * W_LAYER; float* RS = (float*)(ws + WS_CTL);
        pg8::Gemm g{(const bf16*)(ws + WS_HB), (const bf16*)(wl + W_GU), MPAD, 2 * DFF, DM}; pg8::StaticOrder S; S.init(MPAD, 2 * DFF, G, (int)blockIdx.x);
        pg8::EpiGU E{RS + (2 * L + 1) * RS_STRIDE, (bf16*)(ws + WS_HID), args.in[21] + (size_t)L * 3 * DFF, args.in[22] + L * DFF, (float*)(ws + WS_SIDEA), (float*)(ws + WS_SIDEU), (float*)(ws + WS_METAA)};
        pg8::gemm_phase<pg8::EpiGU, pg8::StaticOrder, true, true>(lds, g, S, E);
    }
    SEAM(P + 5);
    if (IN(P + 6) && PH_ON(6)) {
        int tid = threadIdx.x; asm volatile("" : "+v"(tid));
        const float* cw = args.in[21] + (size_t)L * 3 * DFF; const float* cb = args.in[22] + L * DFF;
        const float* sideA = (const float*)(ws + WS_SIDEA); const float* sideU = (const float*)(ws + WS_SIDEU); const float* metaA = (const float*)(ws + WS_METAA); bf16* HID = (bf16*)(ws + WS_HID);
        const int gt = blockIdx.x * NTHREADS + tid, NGT = G * NTHREADS; constexpr int F4 = DFF / 4;
        for (int i = gt; i < 513 * 2 * F4; i += NGT) {
            const int f = (i % F4) * 4, sr = i / F4, r = sr & 1, seg = sr >> 1;
            const f32x4 z4 = {0.f, 0.f, 0.f, 0.f};
            const f32x4 a0 = *(const f32x4*)(sideA + (size_t)(seg * 4 + 0) * DFF + f), a1 = *(const f32x4*)(sideA + (size_t)(seg * 4 + 1) * DFF + f);
            f32x4 h0, h1;
            if (seg == 512) { h0 = z4; h1 = z4; }
            else if ((seg & 31) == 0) { h0 = *(const f32x4*)(metaA + f); h1 = *(const f32x4*)(metaA + DFF + f); }
            else { h0 = *(const f32x4*)(sideA + (size_t)((seg - 1) * 4 + 2) * DFF + f); h1 = *(const f32x4*)(sideA + (size_t)((seg - 1) * 4 + 3) * DFF + f); }
            const f32x4 cur = r ? a1 : a0, p1 = r ? a0 : h1, p2 = r ? h1 : h0;
            const f32x4 w0 = *(const f32x4*)(cw + f), w1 = *(const f32x4*)(cw + DFF + f), w2 = *(const f32x4*)(cw + 2 * DFF + f), bb = *(const f32x4*)(cb + f);
            const f32x4 up = *(const f32x4*)(sideU + (size_t)(seg * 2 + r) * DFF + f);
            const f32x4 cv = bb + w0 * p2 + w1 * p1 + w2 * cur;
            v2u w; w.x = pk2(pg8::silu_f(cv[0]) * up[0], pg8::silu_f(cv[1]) * up[1]); w.y = pk2(pg8::silu_f(cv[2]) * up[2], pg8::silu_f(cv[3]) * up[3]);
            *(v2u*)(HID + (size_t)(seg * 64 + r) * DFF + f) = w;
        }
    }
    SEAM(P + 6);
    if (IN(P + 7) && PH_ON(7)) {
        unsigned char* wl = ws + WS_W + (size_t)L * W_LAYER; float* RS = (float*)(ws + WS_CTL);
        pg8::Gemm g{(const bf16*)(ws + WS_HID), (const bf16*)(wl + W_DN), MPAD, DM, DFF}; pg8::StaticOrder S; S.init(MPAD, DM, G, (int)blockIdx.x);
        pg8::EpiRes E{args.out, args.out, (float*)(ws + WS_HMETA), (bf16*)(ws + WS_HB), RS + (2 * L + 2) * RS_STRIDE};
        pg8::gemm_phase<pg8::EpiRes, pg8::StaticOrder, true, true>(lds, g, S, E);
    }
    SEAM(P + 7);
}

__global__ void __launch_bounds__(NTHREADS) fwd_kernel(Args args) {
    extern __shared__ __attribute__((aligned(16))) unsigned char lds_raw[];
    LAS unsigned char* lds = (LAS unsigned char*)lds_raw;
    const int lo = args.ph_lo, hi = args.ph_hi;
    if (IN(0) && PH_ON(100)) p0_prologue(args, lds);
    SEAM(0);
    layer_phases<0>(args, lds, lo, hi);
    layer_phases<1>(args, lds, lo, hi);
    if (IN(NPHASES - 1) && PH_ON(101)) {
        int tid = threadIdx.x; asm volatile("" : "+v"(tid));
        const int lane = tid & 63, wave = tid >> 6;
        const int gw = blockIdx.x * NWAVES + wave, NGW = gridDim.x * NWAVES; const float* rs = (const float*)(args.ws + WS_CTL) + 4 * RS_STRIDE; const float* gn = args.in[24];
        for (int m = gw; m < MMAIN; m += NGW) {
            const float rstd = rsqrtf(rs[m] * (1.0f / 2048.0f) + EPS); float* row = args.out + (size_t)m * DM;
#pragma unroll
            for (int j = 0; j < 8; ++j) { const f32x4 v = *(const f32x4*)(row + 4 * lane + 256 * j), g4 = *(const f32x4*)(gn + 4 * lane + 256 * j); *(f32x4*)(row + 4 * lane + 256 * j) = v * rstd * g4; }
        }
    }
}
#undef IN
#undef SEAM

extern "C" void kernel_launch(void* const* d_in, const int* in_sizes, int n_in, void* d_out, int out_size, void* d_ws, size_t ws_size, hipStream_t stream) {
    static int grid = 0;
    if (grid == 0) {
        if (n_in != 25 || out_size != MMAIN * DM || ws_size < WS_END) { fprintf(stderr, "kernel_launch: unexpected shapes (n_in %d, out %d, ws %zu < %zu)\n", n_in, out_size, ws_size, (size_t)WS_END); grid = -1; return; }
        int dev = 0, cus = 0, per_cu = 0;
        hipGetDevice(&dev); hipDeviceGetAttribute(&cus, hipDeviceAttributeMultiprocessorCount, dev);
        if (hipFuncSetAttribute((const void*)fwd_kernel, hipFuncAttributeMaxDynamicSharedMemorySize, LDS_BYTES) != hipSuccess) { fprintf(stderr, "kernel_launch: hipFuncSetAttribute failed\n"); grid = -1; return; }
        if (hipOccupancyMaxActiveBlocksPerMultiprocessor(&per_cu, (const void*)fwd_kernel, NTHREADS, LDS_BYTES) != hipSuccess || per_cu < 1) { fprintf(stderr, "kernel_launch: occupancy query gave %d\n", per_cu); per_cu = 1; }
        (void)hipGetLastError();
        grid = cus * 1;
    }
    if (grid < 0) return;
    hipMemsetAsync((char*)d_ws + WS_CTL, 0, CTL_ZERO_BYTES, stream);
    Args a{};
    for (int i = 0; i < 25; ++i) a.in[i] = (const float*)d_in[i];
    a.out = (float*)d_out; a.ws = (unsigned char*)d_ws;
#if ONE_LAUNCH
    a.ph_lo = 0; a.ph_hi = NPHASES;
    void* kargs[] = {&a};
    hipError_t e = hipLaunchCooperativeKernel((const void*)fwd_kernel, dim3(grid), dim3(NTHREADS), kargs, LDS_BYTES, stream);
    if (e != hipSuccess) fprintf(stderr, "kernel_launch: cooperative launch failed: %s (grid %d)\n", hipGetErrorString(e), grid);
#else
    for (int ph = 0; ph < NPHASES; ++ph) { a.ph_lo = ph; a.ph_hi = ph + 1; hipLaunchKernelGGL(fwd_kernel, dim3(grid), dim3(NTHREADS), LDS_BYTES, stream, a); }
#endif
}
```

```cpp
#include <hip/hip_runtime.h>
#include <hip/hip_cooperative_groups.h>
#include <cstdio>
#include <cstdint>
namespace cg = cooperative_groups;
namespace pg8 {
#define PG8_LAS __attribute__((address_space(3)))
typedef unsigned short bf16_t;
typedef short bf16x8 __attribute__((ext_vector_type(8)));
typedef float f32x4 __attribute__((ext_vector_type(4)));
typedef unsigned u32x4 __attribute__((ext_vector_type(4)));
constexpr int BM = 256, BK = 64, HALF = 128, HTB = HALF * BK * 2  , STAGE_BYTES = 8 * HTB, NXCD = 8, WGM = 8;

__host__ __device__ __forceinline__ int lds_byte(int r, int c) { const int st = (r >> 4) * 2 + (c >> 5), rr = r & 15, cc = c & 31, ob = rr * 64 + cc * 2; return st * 1024 + (ob ^ (((ob >> 9) & 1) << 5)); }
__host__ __device__ __forceinline__ void stage_rc(int b, int& R, int& C) { const int st = b / 1024, sb = b % 1024, swz = sb ^ (((sb >> 9) & 1) << 5); R = (st >> 1) * 16 + swz / 64; C = (st & 1) * 32 + (swz % 64) / 2; }
__host__ __device__ __forceinline__ int perm32(int rho) { const int n = rho >> 4, i = rho & 15; return 8 * (i >> 2) + 4 * n + (i & 3); }

struct Unit { int pm, pn; };
struct Gemm { const bf16_t* A; const bf16_t* Bt; int M, N, K; };

struct StaticOrder {
    int nM, nN, nwg, G, c;
    __host__ __device__ void init(int M, int N, int G_, int c_) { nM = M / BM; nN = N / BM; nwg = nM * nN; G = G_; c = c_; }
    __host__ __device__ bool next(int i, Unit& u) const {
        const long L = (long)i * G + c; if (L >= nwg) return false;
        int wgid = (int)L; { const int q = nwg / NXCD, r = nwg % NXCD, xcd = wgid % NXCD, off = wgid / NXCD; wgid = (xcd < r ? xcd * (q + 1) : r * (q + 1) + (xcd - r) * q) + off; }
        const int nig = WGM * nN, gid = wgid / nig, fm = gid * WGM, gsz = (nM - fm) < WGM ? (nM - fm) : WGM;
        u.pm = fm + ((wgid % nig) % gsz); u.pn = (wgid % nig) / gsz; return true;
    }
    __device__ __forceinline__ void a_ready(const Unit&) const {}
    __device__ __forceinline__ void done(const Unit&) const {}
};

__device__ __forceinline__ unsigned cvt_pk_bf16(float lo, float hi) { unsigned r; asm volatile("v_cvt_pk_bf16_f32 %0, %1, %2" : "=v"(r) : "v"(lo), "v"(hi)); return r; }
__device__ __forceinline__ float bf_lo(unsigned w) { return __uint_as_float(w << 16); }
__device__ __forceinline__ float bf_hi(unsigned w) { return __uint_as_float(w & 0xffff0000u); }
__device__ __forceinline__ float sigmoid_f(float x) { return __builtin_amdgcn_rcpf(1.0f + __expf(-x)); }
__device__ __forceinline__ float silu_f(float x) { return x * sigmoid_f(x); }
constexpr int MMAIN_ROWS = 32768;
constexpr float NORM_EPS = 1e-6f;

struct EpiIn {
    static constexpr bool PERM = true, AFTER_DRAIN = false;
    const float* rs; const float* lb;
    bf16_t* Q; bf16_t* Kb; float* LF; bf16_t* V; bf16_t* GS; bf16_t* U;
    static __device__ __forceinline__ void fgate(float z, float lbv, float& kk, float& lf) {
        z = fminf(fmaxf(z, -30.f), 30.f); const float e = __expf(-z), sg = __builtin_amdgcn_rcpf(1.0f + e);
        const float f = lbv + (1.0f - lbv) * sg; lf = __logf(fmaxf(f, 1e-6f)); kk = (1.0f - lbv) * (e * sg); }
    __device__ __forceinline__ void operator()(const f32x4 (&acc)[2][2][4][2], const Unit& u, int wr, int wc, int fr, int fq) const {
        const int seg = u.pn >> 2, colt = (u.pn & 3) * BM;
        const int row0 = u.pm * BM + wr * 64 + fr, col0 = colt + wc * 32 + 8 * fq;
        bf16_t* dst = seg == 0 ? Q : (seg == 1 ? Kb : (seg == 2 ? V : (seg == 3 ? GS : U)));
        float rstd8[2][4]; f32x4 lbv[2][2];
#pragma unroll
        for (int ai = 0; ai < 2; ++ai)
#pragma unroll
            for (int m = 0; m < 4; ++m) rstd8[ai][m] = rs[row0 + ai * HALF + m * 16];
#pragma unroll
        for (int bj = 0; bj < 2; ++bj) { lbv[bj][0] = seg == 1 ? *(const f32x4*)(lb + col0 + bj * HALF) : (f32x4){0.f, 0.f, 0.f, 0.f}; lbv[bj][1] = seg == 1 ? *(const f32x4*)(lb + col0 + bj * HALF + 4) : (f32x4){0.f, 0.f, 0.f, 0.f}; }
#pragma unroll
        for (int ai = 0; ai < 2; ++ai)
#pragma unroll
            for (int m = 0; m < 4; ++m) rstd8[ai][m] = rsqrtf(rstd8[ai][m] * (1.0f / 2048.0f) + NORM_EPS);
#pragma unroll
        for (int ai = 0; ai < 2; ++ai)
#pragma unroll
            for (int m = 0; m < 4; ++m) {
                const int row = row0 + ai * HALF + m * 16;
                const float rstd = rstd8[ai][m];
#pragma unroll
                for (int bj = 0; bj < 2; ++bj) {
                    const int c = col0 + bj * HALF; const size_t off = (size_t)row * 1024 + c;
                    f32x4 v0 = acc[ai][bj][m][0] * rstd, v1 = acc[ai][bj][m][1] * rstd;
                    if (seg == 1) {
                        const f32x4 l0 = lbv[bj][0], l1 = lbv[bj][1];
                        f32x4 k0, k1, f0, f1; float tk, tf;
#define FG(vv, ll, kk, ff, i) fgate(vv[i], ll[i], tk, tf); kk[i] = tk; ff[i] = tf;
                        FG(v0, l0, k0, f0, 0) FG(v0, l0, k0, f0, 1) FG(v0, l0, k0, f0, 2) FG(v0, l0, k0, f0, 3)
                        FG(v1, l1, k1, f1, 0) FG(v1, l1, k1, f1, 1) FG(v1, l1, k1, f1, 2) FG(v1, l1, k1, f1, 3)
#undef FG
                        *(f32x4*)(LF + off) = f0; *(f32x4*)(LF + off + 4) = f1;
                        v0 = k0; v1 = k1;
                    } else if (seg == 0 || seg == 3) {
                        v0 = (f32x4){silu_f(v0[0]), silu_f(v0[1]), silu_f(v0[2]), silu_f(v0[3])}; v1 = (f32x4){silu_f(v1[0]), silu_f(v1[1]), silu_f(v1[2]), silu_f(v1[3])};
                    }
                    u32x4 w; w.x = cvt_pk_bf16(v0[0], v0[1]); w.y = cvt_pk_bf16(v0[2], v0[3]); w.z = cvt_pk_bf16(v1[0], v1[1]); w.w = cvt_pk_bf16(v1[2], v1[3]);
                    *(u32x4*)(dst + off) = w;
                }
            }
    }
};

struct EpiGlu {
    static constexpr bool PERM = true, AFTER_DRAIN = false;
    const bf16_t* Y; const float* bias; bf16_t* MIX; float* rs5;
    __device__ __forceinline__ void operator()(const f32x4 (&acc)[2][2][4][2], const Unit& u, int wr, int wc, int fr, int fq) const {
        const int row0 = u.pm * BM + wr * 64 + fr, col0 = u.pn * BM + wc * 32 + 8 * fq;
        f32x4 bsv[2][2];
#pragma unroll
        for (int bj = 0; bj < 2; ++bj) { bsv[bj][0] = *(const f32x4*)(bias + col0 + bj * HALF); bsv[bj][1] = *(const f32x4*)(bias + col0 + bj * HALF + 4); }
#pragma unroll
        for (int ai = 0; ai < 2; ++ai) {
            u32x4 ywv[4][2];
#pragma unroll
            for (int m = 0; m < 4; ++m)
#pragma unroll
                for (int bj = 0; bj < 2; ++bj) ywv[m][bj] = *(const u32x4*)(Y + (size_t)(row0 + ai * HALF + m * 16) * 1024 + col0 + bj * HALF);
#pragma unroll
            for (int m = 0; m < 4; ++m) {
                const int row = row0 + ai * HALF + m * 16; float ss = 0.f;
#pragma unroll
                for (int bj = 0; bj < 2; ++bj) {
                    const int c = col0 + bj * HALF;
                    const f32x4 b0 = bsv[bj][0], b1 = bsv[bj][1];
                    const u32x4 yw = ywv[m][bj];
                    float y[8] = {bf_lo(yw.x), bf_hi(yw.x), bf_lo(yw.y), bf_hi(yw.y), bf_lo(yw.z), bf_hi(yw.z), bf_lo(yw.w), bf_hi(yw.w)};
                    float o[8];
#pragma unroll
                    for (int j = 0; j < 8; ++j) { const float z = (j < 4 ? acc[ai][bj][m][0][j] + b0[j] : acc[ai][bj][m][1][j - 4] + b1[j - 4]); o[j] = y[j] * sigmoid_f(z); ss += o[j] * o[j]; }
                    u32x4 w; w.x = cvt_pk_bf16(o[0], o[1]); w.y = cvt_pk_bf16(o[2], o[3]); w.z = cvt_pk_bf16(o[4], o[5]); w.w = cvt_pk_bf16(o[6], o[7]);
                    *(u32x4*)(MIX + (size_t)row * 2048 + 1024 + c) = w;
                }
                ss += __shfl_xor(ss, 16); ss += __shfl_xor(ss, 32);
                if (fq == 0) atomicAdd(rs5 + row, ss);
            }
        }
    }
};

struct EpiRes {
    static constexpr bool PERM = false, AFTER_DRAIN = false;
    float* hout; bf16_t* HB; float* rsn;
    __device__ __forceinline__ void operator()(const f32x4 (&acc)[2][2][4][2], const Unit& u, int wr, int wc, int fr, int fq) const {
        typedef unsigned u32x2 __attribute__((ext_vector_type(2)));
        const int row00 = u.pm * BM + wr * 64 + fr, col0 = u.pn * BM + wc * 32 + 4 * fq;
        u32x2 hv[2][2][2];
#pragma unroll
        for (int bj = 0; bj < 2; ++bj)
#pragma unroll
            for (int n = 0; n < 2; ++n) hv[0][bj][n] = *(const u32x2*)(HB + (size_t)row00 * 2048 + col0 + bj * HALF + n * 16);
#pragma unroll
        for (int gi = 0; gi < 8; ++gi) {
            const int ai = gi >> 2, m = gi & 3;
            const int row = row00 + ai * HALF + m * 16; float ss = 0.f;
            if (gi < 7) { const int rown = row00 + ((gi + 1) >> 2) * HALF + ((gi + 1) & 3) * 16;
#pragma unroll
                for (int bj = 0; bj < 2; ++bj)
#pragma unroll
                    for (int n = 0; n < 2; ++n) hv[(gi + 1) & 1][bj][n] = *(const u32x2*)(HB + (size_t)rown * 2048 + col0 + bj * HALF + n * 16); }
#pragma unroll
            for (int bj = 0; bj < 2; ++bj)
#pragma unroll
                for (int n = 0; n < 2; ++n) {
                    const int c = col0 + bj * HALF + n * 16; const u32x2 hw = hv[gi & 1][bj][n];
                    const f32x4 o = (f32x4){bf_lo(hw.x), bf_hi(hw.x), bf_lo(hw.y), bf_hi(hw.y)} + acc[ai][bj][m][n];
                    if (hout) *(f32x4*)(hout + (size_t)row * 2048 + c) = o;
                    ss += (o[0] * o[0] + o[1] * o[1]) + (o[2] * o[2] + o[3] * o[3]);
                    u32x2 w; w.x = cvt_pk_bf16(o[0], o[1]); w.y = cvt_pk_bf16(o[2], o[3]);
                    if (!hout) *(u32x2*)(HB + (size_t)row * 2048 + c) = w;
                }
            ss += __shfl_xor(ss, 16); ss += __shfl_xor(ss, 32);
            if (fq == 0) atomicAdd(rsn + row, ss);
        }
    }
};

template <int N> __device__ __forceinline__ float dpp_shr(float v) { return __builtin_bit_cast(float, __builtin_amdgcn_update_dpp(0, __builtin_bit_cast(int, v), 0x110 + N, 0xf, 0xf, true)); }
template <int N> __device__ __forceinline__ float dpp_shl(float v) { return __builtin_bit_cast(float, __builtin_amdgcn_update_dpp(0, __builtin_bit_cast(int, v), 0x100 + N, 0xf, 0xf, true)); }
struct EpiGU {
    static constexpr bool PERM = true, AFTER_DRAIN = false;
    const float* rs; bf16_t* Hd; const float* cw; const float* cb; float* sideA; float* sideU; float* metaA;
    __device__ __forceinline__ void operator()(const f32x4 (&acc)[2][2][4][2], const Unit& u, int wr, int wc, int fr, int fq) const {
        const int lane = threadIdx.x & 63;
        const int f0 = u.pn * HALF + wc * 32 + 8 * fq;
        float rstd8[2][4]; f32x4 cwv[2][4];
#pragma unroll
        for (int ai = 0; ai < 2; ++ai)
#pragma unroll
            for (int m = 0; m < 4; ++m) rstd8[ai][m] = rs[u.pm * BM + ai * HALF + wr * 64 + fr + m * 16];
#pragma unroll
        for (int n = 0; n < 2; ++n) { const int f = f0 + 4 * n; cwv[n][0] = *(const f32x4*)(cw + f); cwv[n][1] = *(const f32x4*)(cw + 5632 + f); cwv[n][2] = *(const f32x4*)(cw + 2 * 5632 + f); cwv[n][3] = *(const f32x4*)(cb + f); }
#pragma unroll
        for (int ai = 0; ai < 2; ++ai) {
            const int seg = u.pm * 4 + ai * 2 + wr, rowb = u.pm * BM + ai * HALF + wr * 64 + fr;
            float rstd[4];
#pragma unroll
            for (int m = 0; m < 4; ++m) rstd[m] = rsqrtf(rstd8[ai][m] * (1.0f / 2048.0f) + NORM_EPS);
            unsigned pk[4][2][2];
#pragma unroll
            for (int n = 0; n < 2; ++n) {
                const int f = f0 + 4 * n;
                const f32x4 w0 = cwv[n][0], w1 = cwv[n][1], w2 = cwv[n][2], bb = cwv[n][3];
                f32x4 g[4], up[4];
#pragma unroll
                for (int m = 0; m < 4; ++m) { g[m] = acc[ai][0][m][n] * rstd[m]; up[m] = acc[ai][1][m][n] * rstd[m]; }
                if (fr < 2) { *(f32x4*)(sideA + (size_t)(seg * 4 + fr) * 5632 + f) = g[0]; *(f32x4*)(sideU + (size_t)(seg * 2 + fr) * 5632 + f) = up[0]; }
                if (fr >= 14) { *(f32x4*)(sideA + (size_t)(seg * 4 + 2 + fr - 14) * 5632 + f) = g[3];
                    if (u.pm * BM >= MMAIN_ROWS && ai == 0 && wr == 0) *(f32x4*)(metaA + (size_t)(fr - 14) * 5632 + f) = g[0]; }
#pragma unroll
                for (int m = 0; m < 4; ++m) {
                    float hv[4];
#pragma unroll
                    for (int j = 0; j < 4; ++j) {
                        float p1 = dpp_shr<1>(g[m][j]), p2 = dpp_shr<2>(g[m][j]);
                        if (m > 0) { p1 += dpp_shl<15>(g[m > 0 ? m - 1 : 0][j]); p2 += dpp_shl<14>(g[m > 0 ? m - 1 : 0][j]); }
                        const float cv = bb[j] + w0[j] * p2 + w1[j] * p1 + w2[j] * g[m][j];
                        hv[j] = silu_f(cv) * up[m][j];
                    }
                    pk[m][n][0] = cvt_pk_bf16(hv[0], hv[1]); pk[m][n][1] = cvt_pk_bf16(hv[2], hv[3]);
                }
            }
#pragma unroll
            for (int m = 0; m < 4; ++m) { u32x4 w; w.x = pk[m][0][0]; w.y = pk[m][0][1]; w.z = pk[m][1][0]; w.w = pk[m][1][1];
                *(u32x4*)(Hd + (size_t)(rowb + m * 16) * 5632 + f0) = w; }
        }
    }
};

template <class Epi, class Sched, bool ALIGN_EPI = false, bool SP2 = false>
__device__ __forceinline__ void gemm_phase(PG8_LAS unsigned char* lds, const Gemm g, const Sched& S, const Epi& E) {
    int tid_ = threadIdx.x; asm volatile("" : "+v"(tid_));
    const int tid = tid_, wid = __builtin_amdgcn_readfirstlane(tid >> 6), lane = tid & 63, wr = wid >> 2, wc = wid & 3, fr = lane & 15, fq = lane >> 4;
    const int K = g.K, nt = K / BK;
    unsigned voffA[2], voffB[2];
#pragma unroll
    for (int i = 0; i < 2; ++i) { int R, C; stage_rc(tid * 16 + i * 8192, R, C); const int Rb = Epi::PERM ? ((R & ~31) + perm32(R & 31)) : R;
        voffA[i] = (unsigned)(R * K + C) * 2u; voffB[i] = (unsigned)(Rb * K + C) * 2u; }
    const size_t kstep = (size_t)(BK * 2);
    const size_t hstep = (size_t)HALF * K * 2;
    const size_t tstep = 2 * hstep;
    const unsigned ldsw = (unsigned)wid * 1024u;
    const int aoff = lds_byte(wr * 64 + fr, fq * 8), boff = lds_byte(wc * 32 + fr, fq * 8);
#define PG8_SA(b, h) (((b) * 2 + (h)) * HTB)
#define PG8_SB(b, h) ((4 + (b) * 2 + (h)) * HTB)
#define PG8_STAGE(bufoff, gbase, voff) do { _Pragma("unroll") for (int _i = 0; _i < 2; ++_i) \
        __builtin_amdgcn_global_load_lds((const unsigned*)((const char*)(gbase) + (voff)[_i]), (PG8_LAS unsigned*)(lds + (bufoff) + ldsw + _i * 8192), 16, 0, 0); } while (0)
#define PG8_LDA(dst, b, h) do { _Pragma("unroll") for (int m = 0; m < 4; ++m) _Pragma("unroll") for (int k = 0; k < 2; ++k) dst[m][k] = *(const PG8_LAS bf16x8*)(lds + PG8_SA(b, h) + aoff + m * 2048 + k * 1024); } while (0)
#define PG8_LDB(dst, b, h) do { _Pragma("unroll") for (int n = 0; n < 2; ++n) _Pragma("unroll") for (int k = 0; k < 2; ++k) dst[n][k] = *(const PG8_LAS bf16x8*)(lds + PG8_SB(b, h) + boff + n * 2048 + k * 1024); } while (0)
#define PG8_MMA(ai, bj, At, Bt) do { __builtin_amdgcn_s_setprio(1); _Pragma("unroll") for (int m = 0; m < 4; ++m) _Pragma("unroll") for (int n = 0; n < 2; ++n) _Pragma("unroll") for (int k = 0; k < 2; ++k) \
        acc[ai][bj][m][n] = __builtin_amdgcn_mfma_f32_16x16x32_bf16(Bt[n][k], At[m][k], acc[ai][bj][m][n], 0, 0, 0); __builtin_amdgcn_s_setprio(0); } while (0)
#define PG8_WAIT_V(n) asm volatile("s_waitcnt vmcnt(" #n ")" ::: "memory")
#define PG8_WAIT_L(n) asm volatile("s_waitcnt lgkmcnt(" #n ")" ::: "memory")
#define PG8_BAR __builtin_amdgcn_s_barrier()
#define PG8_SCHED __builtin_amdgcn_sched_barrier(0)
    Unit cur, nxt; int ui = 0;
    if (!S.next(0, cur)) return;
    f32x4 acc[2][2][4][2];
#pragma unroll
    for (int a = 0; a < 2; ++a)
#pragma unroll
        for (int b = 0; b < 2; ++b)
#pragma unroll
            for (int m = 0; m < 4; ++m)
#pragma unroll
                for (int n = 0; n < 2; ++n) acc[a][b][m][n] = (f32x4){0.f, 0.f, 0.f, 0.f};
    bf16x8 At[4][2], B0[2][2], B1[2][2];
    const char* cA = (const char*)g.A + (size_t)cur.pm * tstep; const char* cB = (const char*)g.Bt + (size_t)cur.pn * tstep;
    S.a_ready(cur);
    if constexpr (SP2) {
        PG8_STAGE(PG8_SB(0, 0), cB, voffB); PG8_STAGE(PG8_SB(0, 1), cB + hstep, voffB); PG8_STAGE(PG8_SA(0, 0), cA, voffA); PG8_STAGE(PG8_SA(0, 1), cA + hstep, voffA);
        if (wr == 1) PG8_BAR;
        PG8_WAIT_V(2); PG8_BAR;
        PG8_STAGE(PG8_SB(1, 0), cB + kstep, voffB); PG8_STAGE(PG8_SA(1, 0), cA + kstep, voffA); PG8_STAGE(PG8_SB(1, 1), cB + hstep + kstep, voffB);
        PG8_WAIT_V(6); PG8_BAR;
    } else {
        PG8_STAGE(PG8_SB(0, 0), cB, voffB); PG8_STAGE(PG8_SA(0, 0), cA, voffA); PG8_STAGE(PG8_SB(0, 1), cB + hstep, voffB); PG8_STAGE(PG8_SA(0, 1), cA + hstep, voffA);
        if (wr == 1) PG8_BAR;
        PG8_WAIT_V(4); PG8_BAR;
        PG8_STAGE(PG8_SB(1, 0), cB + kstep, voffB); PG8_STAGE(PG8_SA(1, 0), cA + kstep, voffA); PG8_STAGE(PG8_SB(1, 1), cB + hstep + kstep, voffB);
        PG8_WAIT_V(6); PG8_BAR;
    }
    for (;;) {
        const bool has_next = S.next(ui + 1, nxt);
        const char* nA = has_next ? (const char*)g.A + (size_t)nxt.pm * tstep : cA; const char* nB = has_next ? (const char*)g.Bt + (size_t)nxt.pn * tstep : cB;
        for (int t = 0; t < nt; t += 2) {
            const bool last = (t == nt - 2);
            const char* a1 = cA + (size_t)(t + 1) * kstep;
            const char* a2 = last ? nA : cA + (size_t)(t + 2) * kstep; const char* b2 = last ? nB : cB + (size_t)(t + 2) * kstep;
            const char* a3 = a2 + kstep; const char* b3 = b2 + kstep;
            if (last && has_next) S.a_ready(nxt);
            if constexpr (SP2) {
            PG8_LDB(B0, 0, 0); PG8_LDB(B1, 0, 1); PG8_SCHED; PG8_LDA(At, 0, 0); PG8_STAGE(PG8_SA(1, 1), a1 + hstep, voffA);
            PG8_WAIT_V(8); PG8_WAIT_L(0); PG8_BAR; PG8_MMA(0, 0, At, B0); PG8_MMA(0, 1, At, B1); PG8_BAR; PG8_SCHED;
            PG8_LDA(At, 0, 1); PG8_STAGE(PG8_SB(0, 0), b2, voffB); PG8_STAGE(PG8_SB(0, 1), b2 + hstep, voffB); PG8_STAGE(PG8_SA(0, 0), a2, voffA);
            PG8_WAIT_V(8); PG8_WAIT_L(0); PG8_BAR; PG8_MMA(1, 0, At, B0); PG8_MMA(1, 1, At, B1); PG8_BAR; PG8_SCHED;
            PG8_LDB(B0, 1, 0); PG8_LDB(B1, 1, 1); PG8_SCHED; PG8_LDA(At, 1, 0); PG8_STAGE(PG8_SA(0, 1), a2 + hstep, voffA);
            PG8_WAIT_V(8); PG8_WAIT_L(0); PG8_BAR; PG8_MMA(0, 0, At, B0); PG8_MMA(0, 1, At, B1); PG8_BAR; PG8_SCHED;
            PG8_LDA(At, 1, 1); PG8_STAGE(PG8_SB(1, 0), b3, voffB); PG8_STAGE(PG8_SB(1, 1), b3 + hstep, voffB); PG8_STAGE(PG8_SA(1, 0), a3, voffA);
            PG8_WAIT_V(8); PG8_WAIT_L(0); PG8_BAR; PG8_MMA(1, 0, At, B0); PG8_MMA(1, 1, At, B1); PG8_BAR; PG8_SCHED;
            } else {
            PG8_LDB(B0, 0, 0); PG8_SCHED; PG8_LDA(At, 0, 0); PG8_STAGE(PG8_SA(1, 1), a1 + hstep, voffA);
            PG8_WAIT_L(8); PG8_BAR; PG8_WAIT_L(0); PG8_MMA(0, 0, At, B0); PG8_BAR; PG8_SCHED;
            PG8_LDB(B1, 0, 1); PG8_STAGE(PG8_SB(0, 0), b2, voffB);
            PG8_BAR; PG8_WAIT_L(0); PG8_MMA(0, 1, At, B1); PG8_BAR;
            PG8_LDA(At, 0, 1); PG8_STAGE(PG8_SA(0, 0), a2, voffA);
            PG8_BAR; PG8_WAIT_L(0); PG8_MMA(1, 0, At, B0); PG8_BAR; PG8_SCHED;
            PG8_STAGE(PG8_SB(0, 1), b2 + hstep, voffB);
            PG8_WAIT_V(6); PG8_BAR; PG8_MMA(1, 1, At, B1); PG8_BAR;
            PG8_LDB(B0, 1, 0); PG8_SCHED; PG8_LDA(At, 1, 0); PG8_STAGE(PG8_SA(0, 1), a2 + hstep, voffA);
            PG8_WAIT_L(8); PG8_BAR; PG8_WAIT_L(0); PG8_MMA(0, 0, At, B0); PG8_BAR; PG8_SCHED;
            PG8_LDB(B1, 1, 1); PG8_STAGE(PG8_SB(1, 0), b3, voffB);
            PG8_BAR; PG8_WAIT_L(0); PG8_MMA(0, 1, At, B1); PG8_BAR;
            PG8_LDA(At, 1, 1); PG8_STAGE(PG8_SA(1, 0), a3, voffA);
            PG8_BAR; PG8_WAIT_L(0); PG8_MMA(1, 0, At, B0); PG8_BAR; PG8_SCHED;
            PG8_STAGE(PG8_SB(1, 1), b3 + hstep, voffB);
            PG8_WAIT_V(6); PG8_BAR; PG8_MMA(1, 1, At, B1); PG8_BAR;
            }
        }
        if constexpr (ALIGN_EPI) { if (wr == 0) PG8_BAR; }
        if constexpr (!Epi::AFTER_DRAIN) { E(acc, cur, wr, wc, fr, fq); S.done(cur); }
        if (!has_next) break;
#pragma unroll
        for (int a = 0; a < 2; ++a)
#pragma unroll
            for (int b = 0; b < 2; ++b)
#pragma unroll
                for (int m = 0; m < 4; ++m)
#pragma unroll
                    for (int n = 0; n < 2; ++n) acc[a][b][m][n] = (f32x4){0.f, 0.f, 0.f, 0.f};
        cur = nxt; cA = nA; cB = nB; ++ui;
        if constexpr (ALIGN_EPI) { if (wr == 1) PG8_BAR; }
    }
    PG8_WAIT_V(0);
    if constexpr (!ALIGN_EPI) { if (wr == 0) PG8_BAR; }
    PG8_BAR;
    if constexpr (Epi::AFTER_DRAIN) { E.fused(acc, cur, wr, wc, fr, fq, lds, wid, lane); S.done(cur); }
#undef PG8_SA
#undef PG8_SB
#undef PG8_STAGE
#undef PG8_LDA
#undef PG8_LDB
#undef PG8_MMA
#undef PG8_WAIT_V
#undef PG8_WAIT_L
#undef PG8_BAR
#undef PG8_SCHED
}
}
#define LAS __attribute__((address_space(3)))
typedef unsigned short bf16;
typedef float f32x4 __attribute__((ext_vector_type(4)));
typedef unsigned v4u __attribute__((ext_vector_type(4)));
typedef unsigned v2u __attribute__((ext_vector_type(2)));
typedef short bf16x8 __attribute__((ext_vector_type(8)));
constexpr int DM = 2048, SEQ = 2048, BATCH = 16, NMETA = 16, DEPTH = 2;
constexpr int DHG = 1024, DS5 = 1024, DIN = 5120, DFF = 5632;
constexpr int MMAIN = BATCH * SEQ;
constexpr int META0 = MMAIN;
constexpr int MPAD = MMAIN + 256;
constexpr int NSEGS = MPAD / 64;
constexpr float EPS = 1e-6f;
constexpr int NWAVES = 8, NTHREADS = 512;
constexpr int LDS_BYTES = 147456;

constexpr size_t MiB = 1u << 20;
constexpr size_t WS_CTL = 0, CTL_ZERO_BYTES = 2 * MiB;
constexpr size_t WS_BAR_OFF = 1 * MiB;
constexpr size_t RS_STRIDE = MPAD;
constexpr size_t WS_S5A = 2 * MiB;
constexpr size_t WS_S5B = 2 * MiB + 128 * 1024;
constexpr size_t WS_LB = 3 * MiB + 512 * 1024;
constexpr size_t WS_HMETA = 4 * MiB;
constexpr size_t WS_METAA = 6 * MiB;
constexpr size_t WS_W = 8 * MiB, W_LAYER = 96 * MiB;
constexpr size_t W_IN = 0, W_GLU = 20 * MiB, W_OUT = 22 * MiB, W_GU = 30 * MiB, W_DN = 74 * MiB;
constexpr size_t WS_HB = 200 * MiB;
constexpr size_t WS_MIX = 329 * MiB;
constexpr size_t WS_SIDEA = WS_MIX, WS_SIDEU = WS_MIX + 48 * MiB;
constexpr size_t WS_R = 458 * MiB;
constexpr size_t PB = (size_t)MPAD * 1024 * 2;
constexpr size_t WS_Q = WS_R, WS_K = WS_R + PB, WS_V = WS_R + 2 * PB, WS_GS = WS_R + 3 * PB, WS_U = WS_R + 4 * PB, WS_LF = WS_R + 5 * PB;
constexpr size_t WS_HID = WS_R;
constexpr size_t WS_Y = WS_R + 7 * PB;
constexpr size_t WS_END = WS_R + 8 * PB;
static_assert((size_t)NSEGS * 4 * 5632 * 4 <= 48 * MiB && WS_SIDEU + (size_t)NSEGS * 2 * 5632 * 4 <= WS_R, "side buffers inside the mix region");
static_assert((size_t)MPAD * 5632 * 2 <= 7 * PB && WS_END <= 1024 * MiB, "workspace map");

__device__ __forceinline__ unsigned f2bf(float f) { unsigned u = __builtin_bit_cast(unsigned, f); return (u + 0x7fffu + ((u >> 16) & 1u)) >> 16; }
__device__ __forceinline__ unsigned pk2(float lo, float hi) { return f2bf(lo) | (f2bf(hi) << 16); }
__device__ __forceinline__ float bflo(unsigned w) { return __uint_as_float(w << 16); }
__device__ __forceinline__ float bfhi(unsigned w) { return __uint_as_float(w & 0xffff0000u); }
__device__ __forceinline__ float wave_sum(float v) {
#pragma unroll
    for (int o = 1; o < 64; o <<= 1) v += __shfl_xor(v, o);
    return v;
}
#define LDS_WAIT() asm volatile("s_waitcnt lgkmcnt(0)" ::: "memory")
#define LDS_BAR() asm volatile("s_waitcnt lgkmcnt(0)\n\ts_barrier" ::: "memory")

struct Args { const float* in[25]; float* out; unsigned char* ws; int ph_lo, ph_hi; };

__device__ __forceinline__ void transpose_item(const float* W, int K, int N, bf16* WT, int drow0, const float* kscale, LAS float* scr, int k0, int n0, int lane) {
    const int lr = lane >> 4, lc = (lane & 15) * 4;
    f32x4 v[16];
#pragma unroll
    for (int i = 0; i < 16; ++i) v[i] = *(const f32x4*)(W + (size_t)(k0 + 4 * i + lr) * N + n0 + lc);
#pragma unroll
    for (int i = 0; i < 16; ++i) { const int kk = 4 * i + lr; const float sc = kscale ? kscale[k0 + kk] : 1.0f; LAS float* p = scr + kk * 65 + lc;
        p[0] = v[i][0] * sc; p[1] = v[i][1] * sc; p[2] = v[i][2] * sc; p[3] = v[i][3] * sc; }
    LDS_WAIT(); asm volatile("" ::: "memory");
    const int c = lane & 7;
#pragma unroll
    for (int j = 0; j < 8; ++j) { const int n = (lane >> 3) + 8 * j; const LAS float* s = scr + (8 * c) * 65 + n;
        v4u o; o.x = pk2(s[0 * 65], s[1 * 65]); o.y = pk2(s[2 * 65], s[3 * 65]); o.z = pk2(s[4 * 65], s[5 * 65]); o.w = pk2(s[6 * 65], s[7 * 65]);
        *(v4u*)(WT + (size_t)(drow0 + n) * K + k0 + 8 * c) = o; }
    LDS_WAIT(); asm volatile("" ::: "memory");
}

__device__ __forceinline__ void p0_prologue(const Args& a, LAS unsigned char* lds) {
    int tid = threadIdx.x; asm volatile("" : "+v"(tid));
    const int lane = tid & 63, wave = tid >> 6;
    const int gw = blockIdx.x * NWAVES + wave, NGW = gridDim.x * NWAVES;
    unsigned char* ws = a.ws;
    LAS float* scr = (LAS float*)(lds + wave * 16640);
    constexpr int I_IN = 32 * 80, I_GLU = 16 * 16, I_OUT = 32 * 32, I_G = 32 * 88, I_DN = 88 * 32, PER_L = I_IN + I_GLU + I_OUT + 2 * I_G + I_DN;
    for (int it = gw; it < DEPTH * PER_L; it += NGW) {
        const int l = it / PER_L; int r = it % PER_L;
        unsigned char* wl = ws + WS_W + (size_t)l * W_LAYER;
        if (r < I_IN) { transpose_item(a.in[4] + (size_t)l * DM * DIN, DM, DIN, (bf16*)(wl + W_IN), 64 * (r % 80), a.in[3] + l * DM, scr, 64 * (r / 80), 64 * (r % 80), lane); continue; } r -= I_IN;
        if (r < I_GLU) { transpose_item(a.in[14] + (size_t)l * DS5 * DS5, DS5, DS5, (bf16*)(wl + W_GLU), 64 * (r % 16), nullptr, scr, 64 * (r / 16), 64 * (r % 16), lane); continue; } r -= I_GLU;
        if (r < I_OUT) { transpose_item(a.in[17] + (size_t)l * DM * DM, DM, DM, (bf16*)(wl + W_OUT), 64 * (r % 32), nullptr, scr, 64 * (r / 32), 64 * (r % 32), lane); continue; } r -= I_OUT;
        if (r < 2 * I_G) { const int up = r >= I_G; if (up) r -= I_G; const int n0 = 64 * (r % 88), drow0 = 256 * (n0 / 128) + (n0 % 128) + (up ? 128 : 0);
            transpose_item(a.in[up ? 20 : 19] + (size_t)l * DM * DFF, DM, DFF, (bf16*)(wl + W_GU), drow0, a.in[18] + l * DM, scr, 64 * (r / 88), n0, lane); continue; } r -= 2 * I_G;
        transpose_item(a.in[23] + (size_t)l * DFF * DM, DFF, DM, (bf16*)(wl + W_DN), 64 * (r % 32), nullptr, scr, 64 * (r / 32), 64 * (r % 32), lane);
    }
    float* rs0 = (float*)(ws + WS_CTL); bf16* HB = (bf16*)(ws + WS_HB);
    for (int m = gw; m < MPAD; m += NGW) {
        const float* src = m < MMAIN ? a.in[0] + (size_t)m * DM : (m < MMAIN + NMETA ? a.in[1] + (size_t)(m - MMAIN) * DM : nullptr);
        f32x4 v[8]; float ss = 0.f;
#pragma unroll
        for (int j = 0; j < 8; ++j) { v[j] = src ? *(const f32x4*)(src + 4 * lane + 256 * j) : (f32x4){0.f, 0.f, 0.f, 0.f}; ss += (v[j][0] * v[j][0] + v[j][1] * v[j][1]) + (v[j][2] * v[j][2] + v[j][3] * v[j][3]); }
        ss = wave_sum(ss);
#pragma unroll
        for (int j = 0; j < 8; ++j) { v2u w; w.x = pk2(v[j][0], v[j][1]); w.y = pk2(v[j][2], v[j][3]); *(v2u*)(HB + (size_t)m * DM + 4 * lane + 256 * j) = w;
}
        if (lane == 0) rs0[m] = ss;
    }
    const int gt = blockIdx.x * NTHREADS + tid, NGT = gridDim.x * NTHREADS;
    float* S5A = (float*)(ws + WS_S5A); float* S5B = (float*)(ws + WS_S5B); float* LB = (float*)(ws + WS_LB);
    for (int i = gt; i < DEPTH * 64 * 64; i += NGT) {
        const int lg = i >> 6;
        const float are = fminf(a.in[6][i], -1e-4f), aim = a.in[7][i], dt = expf(a.in[8][lg]);
        const float mag = expf(are * dt), abr = mag * cosf(aim * dt), abi = mag * sinf(aim * dt);
        const float den = are * are + aim * aim, xre = abr - 1.0f, xim = abi;
        const float zre = (xre * are + xim * aim) / den, zim = (xim * are - xre * aim) / den;
        S5A[2 * i] = abr; S5A[2 * i + 1] = abi;
        for (int h = 0; h < 16; ++h) { const float br = a.in[9][(size_t)i * 16 + h], bi = a.in[10][(size_t)i * 16 + h];
            S5B[((size_t)i * 16 + h) * 2] = zre * br - zim * bi; S5B[((size_t)i * 16 + h) * 2 + 1] = zre * bi + zim * br; }
    }
    for (int i = gt; i < DHG; i += NGT) {
        const float x0 = a.in[2][i], x1 = a.in[2][DHG + i], mx = fmaxf(x0, x1), e0 = expf(x0 - mx), e1 = expf(x1 - mx), s0 = e0 / (e0 + e1), s1 = e1 / (e0 + e1);
        LB[i] = s0 - s0; LB[DHG + i] = (s0 + s1) - s0;
    }
}

typedef __bf16 bf16x2_t __attribute__((ext_vector_type(2)));
typedef float f32x2_t __attribute__((ext_vector_type(2)));
__device__ __forceinline__ unsigned cvtpk(float lo, float hi) { f32x2_t v = {lo, hi}; bf16x2_t b = __builtin_convertvector(v, bf16x2_t); return __builtin_bit_cast(unsigned, b); }
__device__ __forceinline__ bf16x8 as_frag(unsigned a, unsigned b, unsigned c, unsigned d) { v4u t; t.x = a; t.y = b; t.z = c; t.w = d; return __builtin_bit_cast(bf16x8, t); }
constexpr int HG_RAW = 20480, HG_TILE0 = 2 * HG_RAW, HG_TILE = 21760, HG_SS0 = HG_TILE0 + 2 * HG_TILE;
__device__ __forceinline__ void hg_estage(LAS unsigned char* raw, LAS unsigned char* tile, int d, int tq) {
    const LAS float* RAWG = (const LAS float*)raw; const LAS bf16* RAWQ = (const LAS bf16*)(raw + 8192); const LAS bf16* RAWK = (const LAS bf16*)(raw + 12288); const LAS bf16* RAWV = (const LAS bf16*)(raw + 16384);
    LAS bf16* QA = (LAS bf16*)tile; LAS bf16* QM = (LAS bf16*)(tile + 4352); LAS bf16* KM = (LAS bf16*)(tile + 8704); LAS bf16* KBT = (LAS bf16*)(tile + 13056); LAS bf16* VT = (LAS bf16*)(tile + 17152); LAS float* DEC = (LAS float*)(tile + 21248);
    float g[16];
#pragma unroll
    for (int t = 0; t < 16; ++t) g[t] = RAWG[t * 128 + d];
    const float s0 = (g[0] + g[1]) + (g[2] + g[3]), s1 = (g[4] + g[5]) + (g[6] + g[7]), s2 = (g[8] + g[9]) + (g[10] + g[11]), s3 = (g[12] + g[13]) + (g[14] + g[15]);
    const float b7 = s0 + s1, bl = b7 + (s2 + s3);
    float run = (tq > 0 ? s0 : 0.f) + (tq > 1 ? s1 : 0.f) + (tq > 2 ? s2 : 0.f);
    float kbv[4]; unsigned vv[4];
#pragma unroll
    for (int j = 0; j < 4; ++j) {
        const int t = 4 * tq + j;
        run += RAWG[t * 128 + d];
        const float q = __uint_as_float((unsigned)RAWQ[t * 128 + d] << 16), k = __uint_as_float((unsigned)RAWK[t * 128 + d] << 16);
        vv[j] = RAWV[t * 128 + d];
        const float qa = q * __expf(run), qm = q * __expf(fminf(run - b7, 80.f)), km = k * __expf(fminf(b7 - run, 80.f));
        kbv[j] = k * __expf(bl - run);
        QA[t * 136 + d] = (bf16)cvtpk(qa, 0.f); QM[t * 136 + d] = (bf16)cvtpk(qm, 0.f); KM[t * 136 + d] = (bf16)cvtpk(km, 0.f);
    }
    v2u kw; kw.x = cvtpk(kbv[0], kbv[1]); kw.y = cvtpk(kbv[2], kbv[3]); *(LAS v2u*)(KBT + d * 16 + 4 * tq) = kw;
    v2u vw; vw.x = vv[0] | (vv[1] << 16); vw.y = vv[2] | (vv[3] << 16); *(LAS v2u*)(VT + d * 16 + 4 * tq) = vw;
    if (tq == 0) DEC[d] = __expf(bl);
}
__device__ __forceinline__ f32x4 hg_mstage(const LAS unsigned char* tile, LAS float* SS, f32x4 (&S)[8], int w, int fr, int fq) {
    const LAS bf16* QA = (const LAS bf16*)tile; const LAS bf16* QM = (const LAS bf16*)(tile + 4352); const LAS bf16* KM = (const LAS bf16*)(tile + 8704); const LAS bf16* KBT = (const LAS bf16*)(tile + 13056); const LAS bf16* VT = (const LAS bf16*)(tile + 17152); const LAS float* DEC = (const LAS float*)(tile + 21248);
    const int e0 = 16 * w;
    f32x4 accP = {0.f, 0.f, 0.f, 0.f}, accO = {0.f, 0.f, 0.f, 0.f};
#pragma unroll
    for (int ks = 0; ks < 4; ++ks) { const bf16x8 a = *(const LAS bf16x8*)(KM + fr * 136 + 32 * ks + 8 * fq), bq = *(const LAS bf16x8*)(QM + fr * 136 + 32 * ks + 8 * fq);
        accP = __builtin_amdgcn_mfma_f32_16x16x32_bf16(a, bq, accP, 0, 0, 0); }
    float p[4];
#pragma unroll
    for (int r = 0; r < 4; ++r) p[r] = (4 * fq + r <= fr) ? accP[r] : 0.f;
    const bf16x8 pa = as_frag(cvtpk(p[0], p[1]), cvtpk(p[2], p[3]), 0u, 0u);
    const v2u vt2 = *(const LAS v2u*)(VT + (e0 + fr) * 16 + 4 * fq); const bf16x8 vb = as_frag(vt2.x, vt2.y, 0u, 0u);
#pragma unroll
    for (int ks = 0; ks < 4; ++ks) {
        const bf16x8 sb = as_frag(cvtpk(S[2 * ks][0], S[2 * ks][1]), cvtpk(S[2 * ks][2], S[2 * ks][3]), cvtpk(S[2 * ks + 1][0], S[2 * ks + 1][1]), cvtpk(S[2 * ks + 1][2], S[2 * ks + 1][3]));
        const v2u alo = *(const LAS v2u*)(QA + fr * 136 + 32 * ks + 4 * fq), ahi = *(const LAS v2u*)(QA + fr * 136 + 32 * ks + 16 + 4 * fq);
        accO = __builtin_amdgcn_mfma_f32_16x16x32_bf16(as_frag(alo.x, alo.y, ahi.x, ahi.y), sb, accO, 0, 0, 0); }
    accO = __builtin_amdgcn_mfma_f32_16x16x32_bf16(pa, vb, accO, 0, 0, 0);
#pragma unroll
    for (int T = 0; T < 8; ++T) { const f32x4 dc = *(const LAS f32x4*)(DEC + 16 * T + 4 * fq); S[T] = S[T] * dc;
        const v2u kk = *(const LAS v2u*)(KBT + (16 * T + fr) * 16 + 4 * fq);
        S[T] = __builtin_amdgcn_mfma_f32_16x16x32_bf16(as_frag(kk.x, kk.y, 0u, 0u), vb, S[T], 0, 0, 0); }
    f32x4 sq = accO * accO;
#pragma unroll
    for (int r = 0; r < 4; ++r) { float s = sq[r];
        s += __builtin_bit_cast(float, __builtin_amdgcn_update_dpp(0, __builtin_bit_cast(int, s), 0x128, 0xf, 0xf, false));
        s += __builtin_bit_cast(float, __builtin_amdgcn_update_dpp(0, __builtin_bit_cast(int, s), 0x124, 0xf, 0xf, false));
        s += __builtin_bit_cast(float, __builtin_amdgcn_update_dpp(0, __builtin_bit_cast(int, s), 0x122, 0xf, 0xf, false));
        s += __builtin_bit_cast(float, __builtin_amdgcn_update_dpp(0, __builtin_bit_cast(int, s), 0x121, 0xf, 0xf, false));
        sq[r] = s; }
    if (fr == 0) *(LAS f32x4*)(SS + w * 16 + 4 * fq) = sq;
    return accO;
}
__device__ __forceinline__ void hgrn2_item(LAS unsigned char* lds, const int tid, int b, int h, const bf16* Q, const bf16* Kb, const float* LF, const bf16* V, const bf16* GS, bf16* MIX, const float* gain) {
    const int lane = tid & 63, w = __builtin_amdgcn_readfirstlane(tid >> 6), fr = lane & 15, fq = lane >> 4, e0 = 16 * w;
    const int d = tid & 127, tq = __builtin_amdgcn_readfirstlane(tid >> 7);
    const int gt = tid >> 5, gd = (tid & 31) * 4, bt = (tid & 255) >> 4, bd = (tid & 15) * 8;
    const bool lowhalf = tid < 256;
    const bf16* src0 = lowhalf ? Q : Kb; const int raw0off = lowhalf ? 8192 : 12288;
    f32x4 rg; v4u r0, r1 = {0u, 0u, 0u, 0u};
    f32x4 S[8];
#pragma unroll
    for (int T = 0; T < 8; ++T) S[T] = (f32x4){0.f, 0.f, 0.f, 0.f};
    const float gn = gain[h * 128 + e0 + fr];
#define HG_ROW0(c) ((c) == 0 ? META0 : b * SEQ + 16 * ((c) - 1))
#define HG_L(c) do { const int rn_ = HG_ROW0(c); const size_t go_ = (size_t)(rn_ + gt) * 1024 + h * 128 + gd, bo_ = (size_t)(rn_ + bt) * 1024 + h * 128 + bd; \
        rg = *(const f32x4*)(LF + go_); r0 = *(const v4u*)(src0 + bo_); if (lowhalf) r1 = *(const v4u*)(V + bo_); } while (0)
#define HG_W(c) do { LAS unsigned char* raw_ = lds + ((c) & 1) * HG_RAW; *(LAS f32x4*)(raw_ + (gt * 128 + gd) * 4) = rg; *(LAS v4u*)(raw_ + raw0off + (bt * 128 + bd) * 2) = r0; \
        if (lowhalf) *(LAS v4u*)(raw_ + 16384 + (bt * 128 + bd) * 2) = r1; } while (0)
    HG_L(0);
    HG_W(0); HG_L(1);
    LDS_BAR();
    hg_estage(lds, lds + HG_TILE0, d, tq); HG_W(1); HG_L(2);
    LDS_BAR();
    f32x4 oprev = {0.f, 0.f, 0.f, 0.f}; unsigned short gprev[4] = {0, 0, 0, 0};
    for (int i = 0; i <= 128; ++i) {
        if (i > 0 && (i > 1 || b == 0)) {
            const int row0 = HG_ROW0(i - 1); const LAS float* SSp = (const LAS float*)(lds + HG_SS0 + ((i - 1) & 1) * 512);
            f32x4 tot = {0.f, 0.f, 0.f, 0.f};
#pragma unroll
            for (int ww = 0; ww < 8; ++ww) tot += *(const LAS f32x4*)(SSp + ww * 16 + 4 * fq);
#pragma unroll
            for (int r = 0; r < 4; ++r) { const float rstd = rsqrtf(tot[r] * (1.0f / 128.0f) + EPS);
                MIX[(size_t)(row0 + 4 * fq + r) * 2048 + h * 128 + e0 + fr] = (bf16)cvtpk(oprev[r] * rstd * gn * __uint_as_float((unsigned)gprev[r] << 16), 0.f); }
        }
        if (i + 2 <= 128) HG_W(i + 2);
        if (i + 3 <= 128) HG_L(i + 3);
        { const int row0 = HG_ROW0(i);
#pragma unroll
          for (int r = 0; r < 4; ++r) gprev[r] = GS[(size_t)(row0 + 4 * fq + r) * 1024 + h * 128 + e0 + fr]; }
        hg_estage(lds + ((i + 1) & 1) * HG_RAW, lds + HG_TILE0 + ((i + 1) & 1) * HG_TILE, d, tq);
        oprev = hg_mstage(lds + HG_TILE0 + (i & 1) * HG_TILE, (LAS float*)(lds + HG_SS0 + (i & 1) * 512), S, w, fr, fq);
        LDS_BAR();
    }
    {
        const int row0 = HG_ROW0(128); const LAS float* SSp = (const LAS float*)(lds + HG_SS0);
        f32x4 tot = {0.f, 0.f, 0.f, 0.f};
#pragma unroll
        for (int ww = 0; ww < 8; ++ww) tot += *(const LAS f32x4*)(SSp + ww * 16 + 4 * fq);
#pragma unroll
        for (int r = 0; r < 4; ++r) { const float rstd = rsqrtf(tot[r] * (1.0f / 128.0f) + EPS);
            MIX[(size_t)(row0 + 4 * fq + r) * 2048 + h * 128 + e0 + fr] = (bf16)cvtpk(oprev[r] * rstd * gn * __uint_as_float((unsigned)gprev[r] << 16), 0.f); }
    }
#undef HG_ROW0
#undef HG_L
#undef HG_W
    __syncthreads();
}

__device__ __forceinline__ void s5_item(LAS unsigned char* ldsw, int b, int g, int lane, const bf16* UY, bf16* YO, const float* S5A, const float* S5B, const float* cre, const float* cim, const float* dsk) {
    LAS bf16* Xs = (LAS bf16*)ldsw;
    LAS float* Us = (LAS float*)(ldsw + 4352);
    LAS float* BuT = (LAS float*)(ldsw + 5376);
    const int p = lane, fr = lane & 15, fq = lane >> 4;
    const float ar = S5A[(g * 64 + p) * 2], ai = S5A[(g * 64 + p) * 2 + 1];
    bf16x8 bfr[8], cf[4];
#pragma unroll
    for (int nt = 0; nt < 8; ++nt) { const int col = 16 * nt + fr, pp = col & 63, part = col >> 6;
#pragma unroll
        for (int j = 0; j < 8; ++j) { const float val = fq < 2 ? S5B[((size_t)(g * 64 + pp) * 16 + 8 * fq + j) * 2 + part] : 0.f; bfr[nt][j] = (short)f2bf(val); } }
#pragma unroll
    for (int ks = 0; ks < 4; ++ks)
#pragma unroll
        for (int j = 0; j < 8; ++j) { const int k = 32 * ks + 8 * fq + j; const float val = k < 64 ? cre[(size_t)(g * 16 + fr) * 64 + k] : -cim[(size_t)(g * 16 + fr) * 64 + (k - 64)]; cf[ks][j] = (short)f2bf(val); }
    const float dv = dsk[g * 16 + fr];
    float xr = 0.f, xi = 0.f;
    const int ucol = g * 16 + 8 * (fq & 1);
    v4u ru = {0u, 0u, 0u, 0u};
    if (fq < 2) ru = *(const v4u*)(UY + (size_t)(META0 + fr) * 1024 + ucol);
    for (int c = 0; c <= 128; ++c) {
        const int row0 = c == 0 ? META0 : b * SEQ + 16 * (c - 1);
        const bf16x8 ua = __builtin_bit_cast(bf16x8, ru);
        if (fq < 2) { LAS float* q = Us + fr * 16 + 8 * fq; *(LAS f32x4*)q = (f32x4){bflo(ru.x), bfhi(ru.x), bflo(ru.y), bfhi(ru.y)}; *(LAS f32x4*)(q + 4) = (f32x4){bflo(ru.z), bfhi(ru.z), bflo(ru.w), bfhi(ru.w)}; }
        if (c < 128 && fq < 2) ru = *(const v4u*)(UY + (size_t)(b * SEQ + 16 * c + fr) * 1024 + ucol);
#pragma unroll
        for (int nt = 0; nt < 8; ++nt) { f32x4 acc = {0.f, 0.f, 0.f, 0.f}; acc = __builtin_amdgcn_mfma_f32_16x16x32_bf16(ua, bfr[nt], acc, 0, 0, 0);
#pragma unroll
            for (int r = 0; r < 4; ++r) BuT[(4 * fq + r) * 132 + 16 * nt + fr] = acc[r]; }
        LDS_WAIT(); asm volatile("" ::: "memory");
#pragma unroll
        for (int t = 0; t < 16; ++t) {
            const float bur = BuT[t * 132 + p], bui = BuT[t * 132 + 64 + p];
            const float nxr = ar * xr - ai * xi + bur, nxi = ar * xi + ai * xr + bui; xr = nxr; xi = nxi;
            Xs[t * 136 + p] = (bf16)f2bf(xr); Xs[t * 136 + 64 + p] = (bf16)f2bf(xi);
        }
        LDS_WAIT(); asm volatile("" ::: "memory");
        f32x4 acc = {0.f, 0.f, 0.f, 0.f};
#pragma unroll
        for (int ks = 0; ks < 4; ++ks) { const bf16x8 af = *(const LAS bf16x8*)(Xs + fr * 136 + 32 * ks + 8 * fq); acc = __builtin_amdgcn_mfma_f32_16x16x32_bf16(af, cf[ks], acc, 0, 0, 0); }
#pragma unroll
        for (int r = 0; r < 4; ++r) { const int t = 4 * fq + r; const float uu = Us[t * 16 + fr]; float y = acc[r] + dv * uu;
            const float in = 1.5957691216f * (y + 0.044715f * y * y * y); y = y * __builtin_amdgcn_rcpf(1.0f + __expf(-in));
            if (c > 0 || b == 0) YO[(size_t)(row0 + t) * 1024 + g * 16 + fr] = (bf16)f2bf(y); }
        LDS_WAIT(); asm volatile("" ::: "memory");
    }
}

__device__ __forceinline__ f32x4 meta_kloop(const bf16* W, const bf16* X, int K, int wave, int fr, int fq) {
    f32x4 acc = {0.f, 0.f, 0.f, 0.f};
    const bf16* wp = W + (size_t)fr * K + 8 * fq; const bf16* xp = X + (size_t)fr * K + 8 * fq;
    const int nks = K >> 5;
#pragma unroll 4
    for (int ks = wave; ks < nks; ks += 8) { const bf16x8 a = *(const bf16x8*)(wp + 32 * ks), b = *(const bf16x8*)(xp + 32 * ks); acc = __builtin_amdgcn_mfma_f32_16x16x32_bf16(a, b, acc, 0, 0, 0); }
    return acc;
}
__device__ __forceinline__ f32x4 meta_reduce(LAS float* red, f32x4 acc, int wave, int lane) {
    *(LAS f32x4*)(red + (wave * 64 + lane) * 4) = acc;
    __syncthreads();
    f32x4 s = {0.f, 0.f, 0.f, 0.f};
    if (wave == 0) {
#pragma unroll
        for (int w = 0; w < 8; ++w) s += *(const LAS f32x4*)(red + (w * 64 + lane) * 4);
    }
    __syncthreads();
    return s;
}
struct MetaP { const bf16* W; const bf16* X; int N, K; const float* rs; const float* lb; bf16* Q; bf16* Kb; float* LF; bf16* V; bf16* GS; bf16* U;
               const bf16* Y; const float* bias; bf16* MIX; float* rsacc; float* hmeta; bf16* HB; bf16* Hd; const float* cw; const float* cb; float* metaA; };
template <int MODE> __device__ __forceinline__ void meta_gemm(LAS unsigned char* lds, const MetaP& P) {
    int tid = threadIdx.x; asm volatile("" : "+v"(tid));
    const int lane = tid & 63, wave = __builtin_amdgcn_readfirstlane(tid >> 6), fr = lane & 15, fq = lane >> 4;
    LAS float* red = (LAS float*)lds; LAS float* red2 = red + 2048;
    const int ntiles = (MODE == 3 ? DFF : P.N) / 16, row = META0 + fr;
    for (int nt = blockIdx.x; nt < ntiles; nt += gridDim.x) {
        const int n0 = 16 * nt;
        if (MODE == 3) {
            const int grow = 256 * (n0 >> 7) + (n0 & 127);
            f32x4 ag = meta_kloop(P.W + (size_t)grow * P.K, P.X, P.K, wave, fr, fq), au = meta_kloop(P.W + (size_t)(grow + 128) * P.K, P.X, P.K, wave, fr, fq);
            ag = meta_reduce(red, ag, wave, lane); au = meta_reduce(red2, au, wave, lane);
            if (wave == 0) {
                const float rstd = rsqrtf(P.rs[row] * (1.0f / 2048.0f) + EPS); const int f = n0 + 4 * fq;
                const f32x4 a = ag * rstd, up = au * rstd;
                f32x4 p1, p2;
#pragma unroll
                for (int r = 0; r < 4; ++r) { const float s1 = __shfl(a[r], (lane - 1) & 63), s2 = __shfl(a[r], (lane - 2) & 63); p1[r] = fr >= 1 ? s1 : 0.f; p2[r] = fr >= 2 ? s2 : 0.f; }
                const f32x4 w0 = *(const f32x4*)(P.cw + f), w1 = *(const f32x4*)(P.cw + DFF + f), w2 = *(const f32x4*)(P.cw + 2 * DFF + f), bb = *(const f32x4*)(P.cb + f);
                const f32x4 cv = bb + w0 * p2 + w1 * p1 + w2 * a;
                v2u w; w.x = cvtpk(pg8::silu_f(cv[0]) * up[0], pg8::silu_f(cv[1]) * up[1]); w.y = cvtpk(pg8::silu_f(cv[2]) * up[2], pg8::silu_f(cv[3]) * up[3]);
                *(v2u*)(P.Hd + (size_t)row * DFF + f) = w;
                if (fr >= 14) *(f32x4*)(P.metaA + (size_t)(fr - 14) * DFF + f) = a;
            }
        } else {
            f32x4 acc = meta_kloop(P.W + (size_t)n0 * P.K, P.X, P.K, wave, fr, fq);
            acc = meta_reduce(red, acc, wave, lane);
            if (wave == 0) {
                if (MODE == 0) {
                    const int seg = n0 >> 10, c = (n0 & 1023) + 4 * fq; const size_t off = (size_t)row * 1024 + c;
                    const float rstd = rsqrtf(P.rs[row] * (1.0f / 2048.0f) + EPS);
                    f32x4 v = acc * rstd;
                    if (seg == 1) { const f32x4 l = *(const f32x4*)(P.lb + c); f32x4 kk, lf; float tk, tf;
                        pg8::EpiIn::fgate(v[0], l[0], tk, tf); kk[0] = tk; lf[0] = tf; pg8::EpiIn::fgate(v[1], l[1], tk, tf); kk[1] = tk; lf[1] = tf;
                        pg8::EpiIn::fgate(v[2], l[2], tk, tf); kk[2] = tk; lf[2] = tf; pg8::EpiIn::fgate(v[3], l[3], tk, tf); kk[3] = tk; lf[3] = tf;
                        *(f32x4*)(P.LF + off) = lf; v = kk; }
                    else if (seg == 0 || seg == 3) v = (f32x4){pg8::silu_f(v[0]), pg8::silu_f(v[1]), pg8::silu_f(v[2]), pg8::silu_f(v[3])};
                    bf16* dst = seg == 0 ? P.Q : (seg == 1 ? P.Kb : (seg == 2 ? P.V : (seg == 3 ? P.GS : P.U)));
                    v2u w; w.x = cvtpk(v[0], v[1]); w.y = cvtpk(v[2], v[3]); *(v2u*)(dst + off) = w;
                } else if (MODE == 1) {
                    const int c = n0 + 4 * fq; const v2u yw = *(const v2u*)(P.Y + (size_t)row * 1024 + c); const f32x4 b4 = *(const f32x4*)(P.bias + c);
                    const f32x4 y = {bflo(yw.x), bfhi(yw.x), bflo(yw.y), bfhi(yw.y)}; f32x4 o;
#pragma unroll
                    for (int r = 0; r < 4; ++r) o[r] = y[r] * pg8::sigmoid_f(acc[r] + b4[r]);
                    v2u w; w.x = cvtpk(o[0], o[1]); w.y = cvtpk(o[2], o[3]); *(v2u*)(P.MIX + (size_t)row * 2048 + 1024 + c) = w;
                    float ss = (o[0] * o[0] + o[1] * o[1]) + (o[2] * o[2] + o[3] * o[3]); ss += __shfl_xor(ss, 16); ss += __shfl_xor(ss, 32);
                    if (fq == 0) atomicAdd(P.rsacc + row, ss);
                } else {
                    const int c = n0 + 4 * fq; bf16* hp = P.HB + (size_t)row * 2048 + c; const v2u hw = *(const v2u*)hp;
                    const f32x4 o = (f32x4){bflo(hw.x), bfhi(hw.x), bflo(hw.y), bfhi(hw.y)} + acc;
                    v2u w; w.x = cvtpk(o[0], o[1]); w.y = cvtpk(o[2], o[3]); *(v2u*)hp = w;
                    float ss = (o[0] * o[0] + o[1] * o[1]) + (o[2] * o[2] + o[3] * o[3]); ss += __shfl_xor(ss, 16); ss += __shfl_xor(ss, 32);
                    if (fq == 0) atomicAdd(P.rsacc + row, ss);
                }
            }
        }
    }
    __syncthreads();
}
#define XB_TMO      128
#define XB_XCNT(j)  (256  + 64 * (j))
#define XB_XSUB(j)  (1280 + 64 * (j))
#define XB_XGEN(j)  (2304 + 64 * (j))
#define XB_TOP      3328
#define XB_TOPGEN   3392
#define XCD_BAR_WORDS 3456
#define XB_SPIN_CAP (1u << 18)

__device__ __forceinline__ unsigned xb_ld(unsigned* p)              { return __hip_atomic_load(p, __ATOMIC_RELAXED, __HIP_MEMORY_SCOPE_AGENT); }
__device__ __forceinline__ unsigned xb_add(unsigned* p, unsigned v) { return __hip_atomic_fetch_add(p, v, __ATOMIC_RELAXED, __HIP_MEMORY_SCOPE_AGENT); }
__device__ __forceinline__ unsigned xb_xcc_id() { return (unsigned)__builtin_amdgcn_s_getreg((3 << 11) | 20) & 0xFu; }
#define XB_SPIN(cond, bar) do { unsigned _sp = 0; while (cond) { __builtin_amdgcn_s_sleep(1); \
    if ((++_sp & 255u) == 0u) { if (xb_ld(&(bar)[XB_TMO])) break; if (_sp > XB_SPIN_CAP) { atomicAdd(&(bar)[XB_TMO], 1u); break; } } } } while (0)

struct XcdBarrier {
    unsigned* bar; unsigned x;
    volatile LAS unsigned* st;
};

__device__ __forceinline__ XcdBarrier xcd_barrier_post(unsigned* bar, volatile LAS unsigned* st) {
    XcdBarrier b; b.bar = bar; b.x = xb_xcc_id(); b.st = st;
    if (threadIdx.x == 0) (void)xb_add(&bar[XB_XCNT(b.x)], 1u);
    return b;
}
__device__ __forceinline__ void xcd_barrier_complete(unsigned* bar, unsigned x, unsigned& nloc, unsigned& nx) {
    const unsigned G = gridDim.x * gridDim.y * gridDim.z;
    unsigned sum, cnt, mine, sp = 0u;
    for (;;) {
        sum = 0u; cnt = 0u; mine = 0u;
#pragma unroll
        for (unsigned j = 0; j < 16; ++j) { const unsigned c = xb_ld(&bar[XB_XCNT(j)]); sum += c; cnt += (c > 0u) ? 1u : 0u; mine = (j == x) ? c : mine; }
        if (sum == G) break;
        __builtin_amdgcn_s_sleep(1);
        if ((++sp & 255u) == 0u) { if (xb_ld(&bar[XB_TMO])) break; if (sp > XB_SPIN_CAP) { atomicAdd(&bar[XB_TMO], 1u); break; } }
    }
    nloc = mine > 0u ? mine : 1u; nx = cnt > 0u ? cnt : 1u;
}

__device__ __forceinline__ void xcd_barrier(const XcdBarrier& b) {
    asm volatile("s_waitcnt vmcnt(0)" ::: "memory");
    __syncthreads();
    if (threadIdx.x == 0) {
        unsigned* bar = b.bar;
        __builtin_amdgcn_s_waitcnt(0);
        unsigned nloc = b.st[0], nx = b.st[1];
        if (nloc == 0u) { xcd_barrier_complete(bar, b.x, nloc, nx); b.st[0] = nloc; b.st[1] = nx; }
        const unsigned old = xb_add(&bar[XB_XSUB(b.x)], 1u);
        const unsigned gen = old / nloc;
        if (old + 1u == (gen + 1u) * nloc) {
            __builtin_amdgcn_fence(__ATOMIC_RELEASE, "agent");
            asm volatile("s_waitcnt vmcnt(0)" ::: "memory");
            const unsigned og = xb_add(&bar[XB_TOP], 1u);
            const unsigned tg = og / nx;
            if (og + 1u == (tg + 1u) * nx) xb_add(&bar[XB_TOPGEN], 1u);
            else XB_SPIN(xb_ld(&bar[XB_TOPGEN]) == tg, bar);
            __builtin_amdgcn_fence(__ATOMIC_ACQUIRE, "agent");
            xb_add(&bar[XB_XGEN(b.x)], 1u);
            asm volatile("s_waitcnt vmcnt(0)" ::: "memory");
        } else {
            XB_SPIN(xb_ld(&bar[XB_XGEN(b.x)]) == gen, bar);
            __builtin_amdgcn_fence(__ATOMIC_ACQUIRE, "agent");
            asm volatile("s_waitcnt vmcnt(0)" ::: "memory");
        }
    }
    __syncthreads();
}
#ifndef ONE_LAUNCH
#define ONE_LAUNCH 1
#endif
#ifndef ONLY
#define ONLY -1
#endif
#define PH_ON(k) (ONLY == -1 || ONLY == (k))
#ifndef REP_MIX
#define REP_MIX 1
#endif
#ifndef REP_HG
#define REP_HG 1
#endif
#ifndef REP_S5
#define REP_S5 1
#endif
#ifndef REP_P5
#define REP_P5 1
#endif
#ifndef REP_P1
#define REP_P1 1
#endif
#ifndef REP_P0
#define REP_P0 1
#endif
constexpr int NPHASES = 18;

#define IN(k) (lo <= (k) && (k) < hi)
#define SEAM(k) do { if (IN(k) && IN((k) + 1)) { if ((k) == 0) cg::this_grid().sync(); else xcd_barrier(xbar); } } while (0)

template <int L> __device__ __forceinline__ void layer_phases(const Args& args, LAS unsigned char* lds, const int lo, const int hi, const XcdBarrier& xbar) {
    constexpr int P = 1 + 8 * L;
    unsigned char* const ws = args.ws;
    const int G = gridDim.x;
    if (IN(P + 0) && PH_ON(0)) {
        unsigned char* wl = ws + WS_W + (size_t)L * W_LAYER; float* RS = (float*)(ws + WS_CTL);
        { MetaP mp{}; mp.W = (const bf16*)(wl + W_IN); mp.X = (const bf16*)(ws + WS_HB) + (size_t)META0 * DM; mp.N = DIN; mp.K = DM; mp.rs = RS + (2 * L) * RS_STRIDE; mp.lb = (const float*)(ws + WS_LB) + L * DHG;
          mp.Q = (bf16*)(ws + WS_Q); mp.Kb = (bf16*)(ws + WS_K); mp.LF = (float*)(ws + WS_LF); mp.V = (bf16*)(ws + WS_V); mp.GS = (bf16*)(ws + WS_GS); mp.U = (bf16*)(ws + WS_U); meta_gemm<0>(lds, mp); }
        pg8::Gemm g{(const bf16*)(ws + WS_HB), (const bf16*)(wl + W_IN), MMAIN, DIN, DM}; pg8::StaticOrder S; S.init(MMAIN, DIN, G, (int)blockIdx.x);
        pg8::EpiIn E{RS + (2 * L) * RS_STRIDE, (const float*)(ws + WS_LB) + L * DHG, (bf16*)(ws + WS_Q), (bf16*)(ws + WS_K), (float*)(ws + WS_LF), (bf16*)(ws + WS_V), (bf16*)(ws + WS_GS), (bf16*)(ws + WS_U)};
        for (int rep = 0; rep < REP_P1; ++rep) pg8::gemm_phase<pg8::EpiIn, pg8::StaticOrder, true, true>(lds, g, S, E);
    }
    SEAM(P + 0);
    if (IN(P + 1) && PH_ON(1)) {
        int tid = threadIdx.x; asm volatile("" : "+v"(tid));
        const int lane = tid & 63, wave = __builtin_amdgcn_readfirstlane(tid >> 6);
        for (int rep = 0; rep < REP_MIX; ++rep)
        for (int it = blockIdx.x; it < 256; it += G) {
            if (it < 128) for (int r2 = 0; r2 < REP_HG; ++r2) hgrn2_item(lds, tid, it >> 3, it & 7, (const bf16*)(ws + WS_Q), (const bf16*)(ws + WS_K), (const float*)(ws + WS_LF), (const bf16*)(ws + WS_V), (const bf16*)(ws + WS_GS), (bf16*)(ws + WS_MIX), args.in[5] + L * DHG);
            else { const int idx = (it - 128) * 8 + wave;
                for (int r2 = 0; r2 < REP_S5; ++r2) s5_item(lds + wave * 14336, idx >> 6, idx & 63, lane, (const bf16*)(ws + WS_U), (bf16*)(ws + WS_Y), (const float*)(ws + WS_S5A) + L * 64 * 64 * 2, (const float*)(ws + WS_S5B) + (size_t)L * 64 * 64 * 32,
                        args.in[11] + (size_t)L * 64 * 16 * 64, args.in[12] + (size_t)L * 64 * 16 * 64, args.in[13] + L * DS5);
                __syncthreads(); }
        }
    }
    SEAM(P + 1);
    if (IN(P + 2) && PH_ON(2)) {
        unsigned char* wl = ws + WS_W + (size_t)L * W_LAYER; float* RS = (float*)(ws + WS_CTL);
        { MetaP mp{}; mp.W = (const bf16*)(wl + W_GLU); mp.X = (const bf16*)(ws + WS_Y) + (size_t)META0 * DS5; mp.N = DS5; mp.K = DS5; mp.Y = (const bf16*)(ws + WS_Y); mp.bias = args.in[15] + L * DS5; mp.MIX = (bf16*)(ws + WS_MIX); mp.rsacc = RS + (5 + L) * RS_STRIDE; meta_gemm<1>(lds, mp); }
        pg8::Gemm g{(const bf16*)(ws + WS_Y), (const bf16*)(wl + W_GLU), MMAIN, DS5, DS5}; pg8::StaticOrder S; S.init(MMAIN, DS5, G, (int)blockIdx.x);
        pg8::EpiGlu E{(const bf16*)(ws + WS_Y), args.in[15] + L * DS5, (bf16*)(ws + WS_MIX), RS + (5 + L) * RS_STRIDE};
        pg8::gemm_phase<pg8::EpiGlu, pg8::StaticOrder, true, true>(lds, g, S, E);
    }
    SEAM(P + 2);
    if (IN(P + 3) && PH_ON(3)) {
        int tid = threadIdx.x; asm volatile("" : "+v"(tid));
        const int lane = tid & 63, wave = tid >> 6;
        const int gw = blockIdx.x * NWAVES + wave, NGW = G * NWAVES; const float* rs = (const float*)(ws + WS_CTL) + (5 + L) * RS_STRIDE; const float* gn = args.in[16] + L * DS5; bf16* MIX = (bf16*)(ws + WS_MIX);
        for (int m = gw; m < MMAIN + NMETA; m += NGW) {
            const float rstd = rsqrtf(rs[m] * (1.0f / 1024.0f) + EPS);
#pragma unroll
            for (int j = 0; j < 2; ++j) { bf16* p = MIX + (size_t)m * 2048 + 1024 + 8 * lane + 512 * j; const v4u w = *(const v4u*)p;
                const f32x4 g0 = *(const f32x4*)(gn + 8 * lane + 512 * j), g1 = *(const f32x4*)(gn + 8 * lane + 512 * j + 4);
                v4u o; o.x = pk2(bflo(w.x) * rstd * g0[0], bfhi(w.x) * rstd * g0[1]); o.y = pk2(bflo(w.y) * rstd * g0[2], bfhi(w.y) * rstd * g0[3]);
                o.z = pk2(bflo(w.z) * rstd * g1[0], bfhi(w.z) * rstd * g1[1]); o.w = pk2(bflo(w.w) * rstd * g1[2], bfhi(w.w) * rstd * g1[3]); *(v4u*)p = o; }
        }
    }
    SEAM(P + 3);
    if (IN(P + 4) && PH_ON(4)) {
        unsigned char* wl = ws + WS_W + (size_t)L * W_LAYER; float* RS = (float*)(ws + WS_CTL);
        { MetaP mp{}; mp.W = (const bf16*)(wl + W_OUT); mp.X = (const bf16*)(ws + WS_MIX) + (size_t)META0 * DM; mp.N = DM; mp.K = DM; mp.rsacc = RS + (2 * L + 1) * RS_STRIDE; mp.hmeta = (float*)(ws + WS_HMETA); mp.HB = (bf16*)(ws + WS_HB); meta_gemm<2>(lds, mp); }
        pg8::Gemm g{(const bf16*)(ws + WS_MIX), (const bf16*)(wl + W_OUT), MMAIN, DM, DM}; pg8::StaticOrder S; S.init(MMAIN, DM, G, (int)blockIdx.x);
        pg8::EpiRes E{nullptr, (bf16*)(ws + WS_HB), RS + (2 * L + 1) * RS_STRIDE};
        pg8::gemm_phase<pg8::EpiRes, pg8::StaticOrder, true, true>(lds, g, S, E);
    }
    SEAM(P + 4);
    if (IN(P + 5) && PH_ON(5)) {
        unsigned char* wl = ws + WS_W + (size_t)L * W_LAYER; float* RS = (float*)(ws + WS_CTL);
        { MetaP mp{}; mp.W = (const bf16*)(wl + W_GU); mp.X = (const bf16*)(ws + WS_HB) + (size_t)META0 * DM; mp.N = 2 * DFF; mp.K = DM; mp.rs = RS + (2 * L + 1) * RS_STRIDE; mp.Hd = (bf16*)(ws + WS_HID); mp.cw = args.in[21] + (size_t)L * 3 * DFF; mp.cb = args.in[22] + L * DFF; mp.metaA = (float*)(ws + WS_METAA); meta_gemm<3>(lds, mp); }
        pg8::Gemm g{(const bf16*)(ws + WS_HB), (const bf16*)(wl + W_GU), MMAIN, 2 * DFF, DM}; pg8::StaticOrder S; S.init(MMAIN, 2 * DFF, G, (int)blockIdx.x);
        pg8::EpiGU E{RS + (2 * L + 1) * RS_STRIDE, (bf16*)(ws + WS_HID), args.in[21] + (size_t)L * 3 * DFF, args.in[22] + L * DFF, (float*)(ws + WS_SIDEA), (float*)(ws + WS_SIDEU), (float*)(ws + WS_METAA)};
        for (int rep = 0; rep < REP_P5; ++rep) pg8::gemm_phase<pg8::EpiGU, pg8::StaticOrder, true, true>(lds, g, S, E);
    }
    SEAM(P + 5);
    if (IN(P + 6) && PH_ON(6)) {
        int tid = threadIdx.x; asm volatile("" : "+v"(tid));
        const float* cw = args.in[21] + (size_t)L * 3 * DFF; const float* cb = args.in[22] + L * DFF;
        const float* sideA = (const float*)(ws + WS_SIDEA); const float* sideU = (const float*)(ws + WS_SIDEU); const float* metaA = (const float*)(ws + WS_METAA); bf16* HID = (bf16*)(ws + WS_HID);
        const int gt = blockIdx.x * NTHREADS + tid, NGT = G * NTHREADS; constexpr int F4 = DFF / 4;
        for (int i = gt; i < 512 * 2 * F4; i += NGT) {
            const int f = (i % F4) * 4, sr = i / F4, r = sr & 1, seg = sr >> 1;
            const f32x4 a0 = *(const f32x4*)(sideA + (size_t)(seg * 4 + 0) * DFF + f), a1 = *(const f32x4*)(sideA + (size_t)(seg * 4 + 1) * DFF + f);
            f32x4 h0, h1;
            if ((seg & 31) == 0) { h0 = *(const f32x4*)(metaA + f); h1 = *(const f32x4*)(metaA + DFF + f); }
            else { h0 = *(const f32x4*)(sideA + (size_t)((seg - 1) * 4 + 2) * DFF + f); h1 = *(const f32x4*)(sideA + (size_t)((seg - 1) * 4 + 3) * DFF + f); }
            const f32x4 cur = r ? a1 : a0, p1 = r ? a0 : h1, p2 = r ? h1 : h0;
            const f32x4 w0 = *(const f32x4*)(cw + f), w1 = *(const f32x4*)(cw + DFF + f), w2 = *(const f32x4*)(cw + 2 * DFF + f), bb = *(const f32x4*)(cb + f);
            const f32x4 up = *(const f32x4*)(sideU + (size_t)(seg * 2 + r) * DFF + f);
            const f32x4 cv = bb + w0 * p2 + w1 * p1 + w2 * cur;
            v2u w; w.x = pk2(pg8::silu_f(cv[0]) * up[0], pg8::silu_f(cv[1]) * up[1]); w.y = pk2(pg8::silu_f(cv[2]) * up[2], pg8::silu_f(cv[3]) * up[3]);
            *(v2u*)(HID + (size_t)(seg * 64 + r) * DFF + f) = w;
        }
    }
    SEAM(P + 6);
    if (IN(P + 7) && PH_ON(7)) {
        unsigned char* wl = ws + WS_W + (size_t)L * W_LAYER; float* RS = (float*)(ws + WS_CTL);
        { MetaP mp{}; mp.W = (const bf16*)(wl + W_DN); mp.X = (const bf16*)(ws + WS_HID) + (size_t)META0 * DFF; mp.N = DM; mp.K = DFF; mp.rsacc = RS + (2 * L + 2) * RS_STRIDE; mp.hmeta = (float*)(ws + WS_HMETA); mp.HB = (bf16*)(ws + WS_HB); meta_gemm<2>(lds, mp); }
        pg8::Gemm g{(const bf16*)(ws + WS_HID), (const bf16*)(wl + W_DN), MMAIN, DM, DFF}; pg8::StaticOrder S; S.init(MMAIN, DM, G, (int)blockIdx.x);
        pg8::EpiRes E{L == DEPTH - 1 ? args.out : nullptr, (bf16*)(ws + WS_HB), RS + (2 * L + 2) * RS_STRIDE};
        pg8::gemm_phase<pg8::EpiRes, pg8::StaticOrder, true, true>(lds, g, S, E);
    }
    SEAM(P + 7);
}

__global__ void __launch_bounds__(NTHREADS) fwd_kernel(Args args) {
    extern __shared__ __attribute__((aligned(16))) unsigned char lds_raw[];
    LAS unsigned char* lds = (LAS unsigned char*)lds_raw;
    const int lo = args.ph_lo, hi = args.ph_hi;
    volatile LAS unsigned* xst = (volatile LAS unsigned*)(lds + LDS_BYTES - 64);
    if (threadIdx.x < 2) xst[threadIdx.x] = 0u;
    __syncthreads();
    const XcdBarrier xbar = xcd_barrier_post((unsigned*)(args.ws + WS_CTL + WS_BAR_OFF), xst);
    if (IN(0) && PH_ON(100)) { for (int rep = 0; rep < REP_P0; ++rep) p0_prologue(args, lds); }
    SEAM(0);
    layer_phases<0>(args, lds, lo, hi, xbar);
    layer_phases<1>(args, lds, lo, hi, xbar);
    if (IN(NPHASES - 1) && PH_ON(101)) {
        int tid = threadIdx.x; asm volatile("" : "+v"(tid));
        const int lane = tid & 63, wave = tid >> 6;
        const int gw = blockIdx.x * NWAVES + wave, NGW = gridDim.x * NWAVES; const float* rs = (const float*)(args.ws + WS_CTL) + 4 * RS_STRIDE; const float* gn = args.in[24];
        for (int m = gw; m < MMAIN; m += NGW) {
            const float rstd = rsqrtf(rs[m] * (1.0f / 2048.0f) + EPS); float* row = args.out + (size_t)m * DM;
#pragma unroll
            for (int j = 0; j < 8; ++j) { const f32x4 v = *(const f32x4*)(row + 4 * lane + 256 * j), g4 = *(const f32x4*)(gn + 4 * lane + 256 * j); *(f32x4*)(row + 4 * lane + 256 * j) = v * rstd * g4; }
        }
    }
}
#undef IN
#undef SEAM

extern "C" void kernel_launch(void* const* d_in, const int* in_sizes, int n_in, void* d_out, int out_size, void* d_ws, size_t ws_size, hipStream_t stream) {
    static int grid = 0;
    if (grid == 0) {
        if (n_in != 25 || out_size != MMAIN * DM || ws_size < WS_END) { fprintf(stderr, "kernel_launch: unexpected shapes (n_in %d, out %d, ws %zu < %zu)\n", n_in, out_size, ws_size, (size_t)WS_END); grid = -1; return; }
        int dev = 0, cus = 0, per_cu = 0;
        hipGetDevice(&dev); hipDeviceGetAttribute(&cus, hipDeviceAttributeMultiprocessorCount, dev);
        if (hipFuncSetAttribute((const void*)fwd_kernel, hipFuncAttributeMaxDynamicSharedMemorySize, LDS_BYTES) != hipSuccess) { fprintf(stderr, "kernel_launch: hipFuncSetAttribute failed\n"); grid = -1; return; }
        if (hipOccupancyMaxActiveBlocksPerMultiprocessor(&per_cu, (const void*)fwd_kernel, NTHREADS, LDS_BYTES) != hipSuccess || per_cu < 1) { fprintf(stderr, "kernel_launch: occupancy query gave %d\n", per_cu); per_cu = 1; }
        (void)hipGetLastError();
        grid = cus * 1;
    }
    if (grid < 0) return;
    hipMemsetAsync((char*)d_ws + WS_CTL, 0, CTL_ZERO_BYTES, stream);
    Args a{};
    for (int i = 0; i < 25; ++i) a.in[i] = (const float*)d_in[i];
    a.out = (float*)d_out; a.ws = (unsigned char*)d_ws;
#if ONE_LAUNCH
    a.ph_lo = 0; a.ph_hi = NPHASES;
    void* kargs[] = {&a};
    hipError_t e = hipLaunchCooperativeKernel((const void*)fwd_kernel, dim3(grid), dim3(NTHREADS), kargs, LDS_BYTES, stream);
    if (e != hipSuccess) fprintf(stderr, "kernel_launch: cooperative launch failed: %s (grid %d)\n", hipGetErrorString(e), grid);
#else
    for (int ph = 0; ph < NPHASES; ++ph) { a.ph_lo = ph; a.ph_hi = ph + 1; hipLaunchKernelGGL(fwd_kernel, dim3(grid), dim3(NTHREADS), LDS_BYTES, stream, a); }
#endif
}
```

```cpp
#include <hip/hip_runtime.h>
#include <hip/hip_cooperative_groups.h>
#include <cstdio>
#include <cstdint>
namespace cg = cooperative_groups;
namespace pg8 {
#define PG8_LAS __attribute__((address_space(3)))
typedef unsigned short bf16_t;
typedef short bf16x8 __attribute__((ext_vector_type(8)));
typedef float f32x4 __attribute__((ext_vector_type(4)));
typedef unsigned u32x4 __attribute__((ext_vector_type(4)));
constexpr int BM = 256, BK = 64, HALF = 128, HTB = HALF * BK * 2  , STAGE_BYTES = 8 * HTB, NXCD = 8, WGM = 8;

__host__ __device__ __forceinline__ int lds_byte(int r, int c) { const int st = (r >> 4) * 2 + (c >> 5), rr = r & 15, cc = c & 31, ob = rr * 64 + cc * 2; return st * 1024 + (ob ^ (((ob >> 9) & 1) << 5)); }
__host__ __device__ __forceinline__ void stage_rc(int b, int& R, int& C) { const int st = b / 1024, sb = b % 1024, swz = sb ^ (((sb >> 9) & 1) << 5); R = (st >> 1) * 16 + swz / 64; C = (st & 1) * 32 + (swz % 64) / 2; }
__host__ __device__ __forceinline__ int perm32(int rho) { const int n = rho >> 4, i = rho & 15; return 8 * (i >> 2) + 4 * n + (i & 3); }

struct Unit { int pm, pn; };
struct Gemm { const bf16_t* A; const bf16_t* Bt; int M, N, K; };

struct StaticOrder {
    int nM, nN, nwg, G, c;
    __host__ __device__ void init(int M, int N, int G_, int c_) { nM = M / BM; nN = N / BM; nwg = nM * nN; G = G_; c = c_; }
    __host__ __device__ bool next(int i, Unit& u) const {
        const long L = (long)i * G + c; if (L >= nwg) return false;
        int wgid = (int)L; { const int q = nwg / NXCD, r = nwg % NXCD, xcd = wgid % NXCD, off = wgid / NXCD; wgid = (xcd < r ? xcd * (q + 1) : r * (q + 1) + (xcd - r) * q) + off; }
        const int nig = WGM * nN, gid = wgid / nig, fm = gid * WGM, gsz = (nM - fm) < WGM ? (nM - fm) : WGM;
        u.pm = fm + ((wgid % nig) % gsz); u.pn = (wgid % nig) / gsz; return true;
    }
    __device__ __forceinline__ void a_ready(const Unit&) const {}
    __device__ __forceinline__ void done(const Unit&) const {}
};

__device__ __forceinline__ unsigned cvt_pk_bf16(float lo, float hi) { unsigned r; asm volatile("v_cvt_pk_bf16_f32 %0, %1, %2" : "=v"(r) : "v"(lo), "v"(hi)); return r; }
__device__ __forceinline__ float bf_lo(unsigned w) { return __uint_as_float(w << 16); }
__device__ __forceinline__ float bf_hi(unsigned w) { return __uint_as_float(w & 0xffff0000u); }
__device__ __forceinline__ float sigmoid_f(float x) { return __builtin_amdgcn_rcpf(1.0f + __expf(-x)); }
__device__ __forceinline__ float silu_f(float x) { return x * sigmoid_f(x); }
constexpr int MMAIN_ROWS = 32768;
constexpr float NORM_EPS = 1e-6f;

struct EpiIn {
    static constexpr bool PERM = true, AFTER_DRAIN = false;
    const float* rs; const float* lb;
    bf16_t* Q; bf16_t* Kb; float* LF; bf16_t* V; bf16_t* GS; bf16_t* U;
    static __device__ __forceinline__ void fgate(float z, float lbv, float& kk, float& lf) {
        z = fminf(fmaxf(z, -30.f), 30.f); const float e = __expf(-z), sg = __builtin_amdgcn_rcpf(1.0f + e);
        const float f = lbv + (1.0f - lbv) * sg; lf = __logf(fmaxf(f, 1e-6f)); kk = (1.0f - lbv) * (e * sg); }
    __device__ __forceinline__ void operator()(const f32x4 (&acc)[2][2][4][2], const Unit& u, int wr, int wc, int fr, int fq) const {
        const int seg = u.pn >> 2, colt = (u.pn & 3) * BM;
        const int row0 = u.pm * BM + wr * 64 + fr, col0 = colt + wc * 32 + 8 * fq;
        bf16_t* dst = seg == 0 ? Q : (seg == 1 ? Kb : (seg == 2 ? V : (seg == 3 ? GS : U)));
        float rstd8[2][4]; f32x4 lbv[2][2];
#pragma unroll
        for (int ai = 0; ai < 2; ++ai)
#pragma unroll
            for (int m = 0; m < 4; ++m) rstd8[ai][m] = rs[row0 + ai * HALF + m * 16];
#pragma unroll
        for (int bj = 0; bj < 2; ++bj) { lbv[bj][0] = seg == 1 ? *(const f32x4*)(lb + col0 + bj * HALF) : (f32x4){0.f, 0.f, 0.f, 0.f}; lbv[bj][1] = seg == 1 ? *(const f32x4*)(lb + col0 + bj * HALF + 4) : (f32x4){0.f, 0.f, 0.f, 0.f}; }
#pragma unroll
        for (int ai = 0; ai < 2; ++ai)
#pragma unroll
            for (int m = 0; m < 4; ++m) rstd8[ai][m] = rsqrtf(rstd8[ai][m] * (1.0f / 2048.0f) + NORM_EPS);
#pragma unroll
        for (int ai = 0; ai < 2; ++ai)
#pragma unroll
            for (int m = 0; m < 4; ++m) {
                const int row = row0 + ai * HALF + m * 16;
                const float rstd = rstd8[ai][m];
#pragma unroll
                for (int bj = 0; bj < 2; ++bj) {
                    const int c = col0 + bj * HALF; const size_t off = (size_t)row * 1024 + c;
                    f32x4 v0 = acc[ai][bj][m][0] * rstd, v1 = acc[ai][bj][m][1] * rstd;
                    if (seg == 1) {
                        const f32x4 l0 = lbv[bj][0], l1 = lbv[bj][1];
                        f32x4 k0, k1, f0, f1; float tk, tf;
#define FG(vv, ll, kk, ff, i) fgate(vv[i], ll[i], tk, tf); kk[i] = tk; ff[i] = tf;
                        FG(v0, l0, k0, f0, 0) FG(v0, l0, k0, f0, 1) FG(v0, l0, k0, f0, 2) FG(v0, l0, k0, f0, 3)
                        FG(v1, l1, k1, f1, 0) FG(v1, l1, k1, f1, 1) FG(v1, l1, k1, f1, 2) FG(v1, l1, k1, f1, 3)
#undef FG
                        *(f32x4*)(LF + off) = f0; *(f32x4*)(LF + off + 4) = f1;
                        v0 = k0; v1 = k1;
                    } else if (seg == 0 || seg == 3) {
                        v0 = (f32x4){silu_f(v0[0]), silu_f(v0[1]), silu_f(v0[2]), silu_f(v0[3])}; v1 = (f32x4){silu_f(v1[0]), silu_f(v1[1]), silu_f(v1[2]), silu_f(v1[3])};
                    }
                    u32x4 w; w.x = cvt_pk_bf16(v0[0], v0[1]); w.y = cvt_pk_bf16(v0[2], v0[3]); w.z = cvt_pk_bf16(v1[0], v1[1]); w.w = cvt_pk_bf16(v1[2], v1[3]);
                    *(u32x4*)(dst + off) = w;
                }
            }
    }
};

struct EpiGlu {
    static constexpr bool PERM = true, AFTER_DRAIN = false;
    const bf16_t* Y; const float* bias; bf16_t* MIX; float* rs5;
    __device__ __forceinline__ void operator()(const f32x4 (&acc)[2][2][4][2], const Unit& u, int wr, int wc, int fr, int fq) const {
        const int row0 = u.pm * BM + wr * 64 + fr, col0 = u.pn * BM + wc * 32 + 8 * fq;
        f32x4 bsv[2][2];
#pragma unroll
        for (int bj = 0; bj < 2; ++bj) { bsv[bj][0] = *(const f32x4*)(bias + col0 + bj * HALF); bsv[bj][1] = *(const f32x4*)(bias + col0 + bj * HALF + 4); }
#pragma unroll
        for (int ai = 0; ai < 2; ++ai) {
            u32x4 ywv[4][2];
#pragma unroll
            for (int m = 0; m < 4; ++m)
#pragma unroll
                for (int bj = 0; bj < 2; ++bj) ywv[m][bj] = *(const u32x4*)(Y + (size_t)(row0 + ai * HALF + m * 16) * 1024 + col0 + bj * HALF);
#pragma unroll
            for (int m = 0; m < 4; ++m) {
                const int row = row0 + ai * HALF + m * 16; float ss = 0.f;
#pragma unroll
                for (int bj = 0; bj < 2; ++bj) {
                    const int c = col0 + bj * HALF;
                    const f32x4 b0 = bsv[bj][0], b1 = bsv[bj][1];
                    const u32x4 yw = ywv[m][bj];
                    float y[8] = {bf_lo(yw.x), bf_hi(yw.x), bf_lo(yw.y), bf_hi(yw.y), bf_lo(yw.z), bf_hi(yw.z), bf_lo(yw.w), bf_hi(yw.w)};
                    float o[8];
#pragma unroll
                    for (int j = 0; j < 8; ++j) { const float z = (j < 4 ? acc[ai][bj][m][0][j] + b0[j] : acc[ai][bj][m][1][j - 4] + b1[j - 4]); o[j] = y[j] * sigmoid_f(z); ss += o[j] * o[j]; }
                    u32x4 w; w.x = cvt_pk_bf16(o[0], o[1]); w.y = cvt_pk_bf16(o[2], o[3]); w.z = cvt_pk_bf16(o[4], o[5]); w.w = cvt_pk_bf16(o[6], o[7]);
                    *(u32x4*)(MIX + (size_t)row * 2048 + 1024 + c) = w;
                }
                ss += __shfl_xor(ss, 16); ss += __shfl_xor(ss, 32);
                if (fq == 0) atomicAdd(rs5 + row, ss);
            }
        }
    }
};

struct EpiRes {
    static constexpr bool PERM = false, AFTER_DRAIN = false;
    float* hout; bf16_t* HB; float* rsn;
    __device__ __forceinline__ void operator()(const f32x4 (&acc)[2][2][4][2], const Unit& u, int wr, int wc, int fr, int fq) const {
        typedef unsigned u32x2 __attribute__((ext_vector_type(2)));
        const int row00 = u.pm * BM + wr * 64 + fr, col0 = u.pn * BM + wc * 32 + 4 * fq;
        u32x2 hv[2][2][2];
#pragma unroll
        for (int bj = 0; bj < 2; ++bj)
#pragma unroll
            for (int n = 0; n < 2; ++n) hv[0][bj][n] = *(const u32x2*)(HB + (size_t)row00 * 2048 + col0 + bj * HALF + n * 16);
#pragma unroll
        for (int gi = 0; gi < 8; ++gi) {
            const int ai = gi >> 2, m = gi & 3;
            const int row = row00 + ai * HALF + m * 16; float ss = 0.f;
            if (gi < 7) { const int rown = row00 + ((gi + 1) >> 2) * HALF + ((gi + 1) & 3) * 16;
#pragma unroll
                for (int bj = 0; bj < 2; ++bj)
#pragma unroll
                    for (int n = 0; n < 2; ++n) hv[(gi + 1) & 1][bj][n] = *(const u32x2*)(HB + (size_t)rown * 2048 + col0 + bj * HALF + n * 16); }
#pragma unroll
            for (int bj = 0; bj < 2; ++bj)
#pragma unroll
                for (int n = 0; n < 2; ++n) {
                    const int c = col0 + bj * HALF + n * 16; const u32x2 hw = hv[gi & 1][bj][n];
                    const f32x4 o = (f32x4){bf_lo(hw.x), bf_hi(hw.x), bf_lo(hw.y), bf_hi(hw.y)} + acc[ai][bj][m][n];
                    if (hout) *(f32x4*)(hout + (size_t)row * 2048 + c) = o;
                    ss += (o[0] * o[0] + o[1] * o[1]) + (o[2] * o[2] + o[3] * o[3]);
                    u32x2 w; w.x = cvt_pk_bf16(o[0], o[1]); w.y = cvt_pk_bf16(o[2], o[3]);
                    if (!hout) *(u32x2*)(HB + (size_t)row * 2048 + c) = w;
                }
            ss += __shfl_xor(ss, 16); ss += __shfl_xor(ss, 32);
            if (fq == 0) atomicAdd(rsn + row, ss);
        }
    }
};

template <int N> __device__ __forceinline__ float dpp_shr(float v) { return __builtin_bit_cast(float, __builtin_amdgcn_update_dpp(0, __builtin_bit_cast(int, v), 0x110 + N, 0xf, 0xf, true)); }
template <int N> __device__ __forceinline__ float dpp_shl(float v) { return __builtin_bit_cast(float, __builtin_amdgcn_update_dpp(0, __builtin_bit_cast(int, v), 0x100 + N, 0xf, 0xf, true)); }
struct EpiGU {
    static constexpr bool PERM = true, AFTER_DRAIN = false;
    const float* rs; bf16_t* Hd; const float* cw; const float* cb; float* sideA; float* sideU; float* metaA;
    __device__ __forceinline__ void operator()(const f32x4 (&acc)[2][2][4][2], const Unit& u, int wr, int wc, int fr, int fq) const {
        const int lane = threadIdx.x & 63;
        const int f0 = u.pn * HALF + wc * 32 + 8 * fq;
        float rstd8[2][4]; f32x4 cwv[2][4];
#pragma unroll
        for (int ai = 0; ai < 2; ++ai)
#pragma unroll
            for (int m = 0; m < 4; ++m) rstd8[ai][m] = rs[u.pm * BM + ai * HALF + wr * 64 + fr + m * 16];
#pragma unroll
        for (int n = 0; n < 2; ++n) { const int f = f0 + 4 * n; cwv[n][0] = *(const f32x4*)(cw + f); cwv[n][1] = *(const f32x4*)(cw + 5632 + f); cwv[n][2] = *(const f32x4*)(cw + 2 * 5632 + f); cwv[n][3] = *(const f32x4*)(cb + f); }
#pragma unroll
        for (int ai = 0; ai < 2; ++ai) {
            const int seg = u.pm * 4 + ai * 2 + wr, rowb = u.pm * BM + ai * HALF + wr * 64 + fr;
            float rstd[4];
#pragma unroll
            for (int m = 0; m < 4; ++m) rstd[m] = rsqrtf(rstd8[ai][m] * (1.0f / 2048.0f) + NORM_EPS);
            unsigned pk[4][2][2];
#pragma unroll
            for (int n = 0; n < 2; ++n) {
                const int f = f0 + 4 * n;
                const f32x4 w0 = cwv[n][0], w1 = cwv[n][1], w2 = cwv[n][2], bb = cwv[n][3];
                f32x4 g[4], up[4];
#pragma unroll
                for (int m = 0; m < 4; ++m) { g[m] = acc[ai][0][m][n] * rstd[m]; up[m] = acc[ai][1][m][n] * rstd[m]; }
                if (fr < 2) { *(f32x4*)(sideA + (size_t)(seg * 4 + fr) * 5632 + f) = g[0]; *(f32x4*)(sideU + (size_t)(seg * 2 + fr) * 5632 + f) = up[0]; }
                if (fr >= 14) { *(f32x4*)(sideA + (size_t)(seg * 4 + 2 + fr - 14) * 5632 + f) = g[3];
                    if (u.pm * BM >= MMAIN_ROWS && ai == 0 && wr == 0) *(f32x4*)(metaA + (size_t)(fr - 14) * 5632 + f) = g[0]; }
#pragma unroll
                for (int m = 0; m < 4; ++m) {
                    float hv[4];
#pragma unroll
                    for (int j = 0; j < 4; ++j) {
                        float p1 = dpp_shr<1>(g[m][j]), p2 = dpp_shr<2>(g[m][j]);
                        if (m > 0) { p1 += dpp_shl<15>(g[m > 0 ? m - 1 : 0][j]); p2 += dpp_shl<14>(g[m > 0 ? m - 1 : 0][j]); }
                        const float cv = bb[j] + w0[j] * p2 + w1[j] * p1 + w2[j] * g[m][j];
                        hv[j] = silu_f(cv) * up[m][j];
                    }
                    pk[m][n][0] = cvt_pk_bf16(hv[0], hv[1]); pk[m][n][1] = cvt_pk_bf16(hv[2], hv[3]);
                }
            }
#pragma unroll
            for (int m = 0; m < 4; ++m) { u32x4 w; w.x = pk[m][0][0]; w.y = pk[m][0][1]; w.z = pk[m][1][0]; w.w = pk[m][1][1];
                *(u32x4*)(Hd + (size_t)(rowb + m * 16) * 5632 + f0) = w; }
        }
    }
};

template <class Epi, class Sched, bool ALIGN_EPI = false, bool SP2 = false>
__device__ __forceinline__ void gemm_phase(PG8_LAS unsigned char* lds, const Gemm g, const Sched& S, const Epi& E) {
    int tid_ = threadIdx.x; asm volatile("" : "+v"(tid_));
    const int tid = tid_, wid = __builtin_amdgcn_readfirstlane(tid >> 6), lane = tid & 63, wr = wid >> 2, wc = wid & 3, fr = lane & 15, fq = lane >> 4;
    const int K = g.K, nt = K / BK;
    unsigned voffA[2], voffB[2];
#pragma unroll
    for (int i = 0; i < 2; ++i) { int R, C; stage_rc(tid * 16 + i * 8192, R, C); const int Rb = Epi::PERM ? ((R & ~31) + perm32(R & 31)) : R;
        voffA[i] = (unsigned)(R * K + C) * 2u; voffB[i] = (unsigned)(Rb * K + C) * 2u; }
    const size_t kstep = (size_t)(BK * 2);
    const size_t hstep = (size_t)HALF * K * 2;
    const size_t tstep = 2 * hstep;
    const unsigned ldsw = (unsigned)wid * 1024u;
    const int aoff = lds_byte(wr * 64 + fr, fq * 8), boff = lds_byte(wc * 32 + fr, fq * 8);
#define PG8_SA(b, h) (((b) * 2 + (h)) * HTB)
#define PG8_SB(b, h) ((4 + (b) * 2 + (h)) * HTB)
#define PG8_STAGE(bufoff, gbase, voff) do { _Pragma("unroll") for (int _i = 0; _i < 2; ++_i) \
        __builtin_amdgcn_global_load_lds((const unsigned*)((const char*)(gbase) + (voff)[_i]), (PG8_LAS unsigned*)(lds + (bufoff) + ldsw + _i * 8192), 16, 0, 0); } while (0)
#define PG8_LDA(dst, b, h) do { _Pragma("unroll") for (int m = 0; m < 4; ++m) _Pragma("unroll") for (int k = 0; k < 2; ++k) dst[m][k] = *(const PG8_LAS bf16x8*)(lds + PG8_SA(b, h) + aoff + m * 2048 + k * 1024); } while (0)
#define PG8_LDB(dst, b, h) do { _Pragma("unroll") for (int n = 0; n < 2; ++n) _Pragma("unroll") for (int k = 0; k < 2; ++k) dst[n][k] = *(const PG8_LAS bf16x8*)(lds + PG8_SB(b, h) + boff + n * 2048 + k * 1024); } while (0)
#define PG8_MMA(ai, bj, At, Bt) do { __builtin_amdgcn_s_setprio(1); _Pragma("unroll") for (int m = 0; m < 4; ++m) _Pragma("unroll") for (int n = 0; n < 2; ++n) _Pragma("unroll") for (int k = 0; k < 2; ++k) \
        acc[ai][bj][m][n] = __builtin_amdgcn_mfma_f32_16x16x32_bf16(Bt[n][k], At[m][k], acc[ai][bj][m][n], 0, 0, 0); __builtin_amdgcn_s_setprio(0); } while (0)
#define PG8_WAIT_V(n) asm volatile("s_waitcnt vmcnt(" #n ")" ::: "memory")
#define PG8_WAIT_L(n) asm volatile("s_waitcnt lgkmcnt(" #n ")" ::: "memory")
#define PG8_BAR __builtin_amdgcn_s_barrier()
#define PG8_SCHED __builtin_amdgcn_sched_barrier(0)
    Unit cur, nxt; int ui = 0;
    if (!S.next(0, cur)) return;
    f32x4 acc[2][2][4][2];
#pragma unroll
    for (int a = 0; a < 2; ++a)
#pragma unroll
        for (int b = 0; b < 2; ++b)
#pragma unroll
            for (int m = 0; m < 4; ++m)
#pragma unroll
                for (int n = 0; n < 2; ++n) acc[a][b][m][n] = (f32x4){0.f, 0.f, 0.f, 0.f};
    bf16x8 At[4][2], B0[2][2], B1[2][2];
    const char* cA = (const char*)g.A + (size_t)cur.pm * tstep; const char* cB = (const char*)g.Bt + (size_t)cur.pn * tstep;
    S.a_ready(cur);
    if constexpr (SP2) {
        PG8_STAGE(PG8_SB(0, 0), cB, voffB); PG8_STAGE(PG8_SB(0, 1), cB + hstep, voffB); PG8_STAGE(PG8_SA(0, 0), cA, voffA); PG8_STAGE(PG8_SA(0, 1), cA + hstep, voffA);
        if (wr == 1) PG8_BAR;
        PG8_WAIT_V(2); PG8_BAR;
        PG8_STAGE(PG8_SB(1, 0), cB + kstep, voffB); PG8_STAGE(PG8_SA(1, 0), cA + kstep, voffA); PG8_STAGE(PG8_SB(1, 1), cB + hstep + kstep, voffB);
        PG8_WAIT_V(6); PG8_BAR;
    } else {
        PG8_STAGE(PG8_SB(0, 0), cB, voffB); PG8_STAGE(PG8_SA(0, 0), cA, voffA); PG8_STAGE(PG8_SB(0, 1), cB + hstep, voffB); PG8_STAGE(PG8_SA(0, 1), cA + hstep, voffA);
        if (wr == 1) PG8_BAR;
        PG8_WAIT_V(4); PG8_BAR;
        PG8_STAGE(PG8_SB(1, 0), cB + kstep, voffB); PG8_STAGE(PG8_SA(1, 0), cA + kstep, voffA); PG8_STAGE(PG8_SB(1, 1), cB + hstep + kstep, voffB);
        PG8_WAIT_V(6); PG8_BAR;
    }
    for (;;) {
        const bool has_next = S.next(ui + 1, nxt);
        const char* nA = has_next ? (const char*)g.A + (size_t)nxt.pm * tstep : cA; const char* nB = has_next ? (const char*)g.Bt + (size_t)nxt.pn * tstep : cB;
        for (int t = 0; t < nt; t += 2) {
            const bool last = (t == nt - 2);
            const char* a1 = cA + (size_t)(t + 1) * kstep;
            const char* a2 = last ? nA : cA + (size_t)(t + 2) * kstep; const char* b2 = last ? nB : cB + (size_t)(t + 2) * kstep;
            const char* a3 = a2 + kstep; const char* b3 = b2 + kstep;
            if (last && has_next) S.a_ready(nxt);
            if constexpr (SP2) {
            PG8_LDB(B0, 0, 0); PG8_LDB(B1, 0, 1); PG8_SCHED; PG8_LDA(At, 0, 0); PG8_STAGE(PG8_SA(1, 1), a1 + hstep, voffA);
            PG8_WAIT_V(8); PG8_WAIT_L(0); PG8_BAR; PG8_MMA(0, 0, At, B0); PG8_MMA(0, 1, At, B1); PG8_BAR; PG8_SCHED;
            PG8_LDA(At, 0, 1); PG8_STAGE(PG8_SB(0, 0), b2, voffB); PG8_STAGE(PG8_SB(0, 1), b2 + hstep, voffB); PG8_STAGE(PG8_SA(0, 0), a2, voffA);
            PG8_WAIT_V(8); PG8_WAIT_L(0); PG8_BAR; PG8_MMA(1, 0, At, B0); PG8_MMA(1, 1, At, B1); PG8_BAR; PG8_SCHED;
            PG8_LDB(B0, 1, 0); PG8_LDB(B1, 1, 1); PG8_SCHED; PG8_LDA(At, 1, 0); PG8_STAGE(PG8_SA(0, 1), a2 + hstep, voffA);
            PG8_WAIT_V(8); PG8_WAIT_L(0); PG8_BAR; PG8_MMA(0, 0, At, B0); PG8_MMA(0, 1, At, B1); PG8_BAR; PG8_SCHED;
            PG8_LDA(At, 1, 1); PG8_STAGE(PG8_SB(1, 0), b3, voffB); PG8_STAGE(PG8_SB(1, 1), b3 + hstep, voffB); PG8_STAGE(PG8_SA(1, 0), a3, voffA);
            PG8_WAIT_V(8); PG8_WAIT_L(0); PG8_BAR; PG8_MMA(1, 0, At, B0); PG8_MMA(1, 1, At, B1); PG8_BAR; PG8_SCHED;
            } else {
            PG8_LDB(B0, 0, 0); PG8_SCHED; PG8_LDA(At, 0, 0); PG8_STAGE(PG8_SA(1, 1), a1 + hstep, voffA);
            PG8_WAIT_L(8); PG8_BAR; PG8_WAIT_L(0); PG8_MMA(0, 0, At, B0); PG8_BAR; PG8_SCHED;
            PG8_LDB(B1, 0, 1); PG8_STAGE(PG8_SB(0, 0), b2, voffB);
            PG8_BAR; PG8_WAIT_L(0); PG8_MMA(0, 1, At, B1); PG8_BAR;
            PG8_LDA(At, 0, 1); PG8_STAGE(PG8_SA(0, 0), a2, voffA);
            PG8_BAR; PG8_WAIT_L(0); PG8_MMA(1, 0, At, B0); PG8_BAR; PG8_SCHED;
            PG8_STAGE(PG8_SB(0, 1), b2 + hstep, voffB);
            PG8_WAIT_V(6); PG8_BAR; PG8_MMA(1, 1, At, B1); PG8_BAR;
            PG8_LDB(B0, 1, 0); PG8_SCHED; PG8_LDA(At, 1, 0); PG8_STAGE(PG8_SA(0, 1), a2 + hstep, voffA);
            PG8_WAIT_L(8); PG8_BAR; PG8_WAIT_L(0); PG8_MMA(0, 0, At, B0); PG8_BAR; PG8_SCHED;
            PG8_LDB(B1, 1, 1); PG8_STAGE(PG8_SB(1, 0), b3, voffB);
            PG8_BAR; PG8_WAIT_L(0); PG8_MMA(0, 1, At, B1); PG8_BAR;
            PG8_LDA(At, 1, 1); PG8_STAGE(PG8_SA(1, 0), a3, voffA);
            PG8_BAR; PG8_WAIT_L(0); PG8_MMA(1, 0, At, B0); PG8_BAR; PG8_SCHED;
            PG8_STAGE(PG8_SB(1, 1), b3 + hstep, voffB);
            PG8_WAIT_V(6); PG8_BAR; PG8_MMA(1, 1, At, B1); PG8_BAR;
            }
        }
        if constexpr (ALIGN_EPI) { if (wr == 0) PG8_BAR; }
        if constexpr (!Epi::AFTER_DRAIN) { E(acc, cur, wr, wc, fr, fq); S.done(cur); }
        if (!has_next) break;
#pragma unroll
        for (int a = 0; a < 2; ++a)
#pragma unroll
            for (int b = 0; b < 2; ++b)
#pragma unroll
                for (int m = 0; m < 4; ++m)
#pragma unroll
                    for (int n = 0; n < 2; ++n) acc[a][b][m][n] = (f32x4){0.f, 0.f, 0.f, 0.f};
        cur = nxt; cA = nA; cB = nB; ++ui;
        if constexpr (ALIGN_EPI) { if (wr == 1) PG8_BAR; }
    }
    PG8_WAIT_V(0);
    if constexpr (!ALIGN_EPI) { if (wr == 0) PG8_BAR; }
    PG8_BAR;
    if constexpr (Epi::AFTER_DRAIN) { E.fused(acc, cur, wr, wc, fr, fq, lds, wid, lane); S.done(cur); }
#undef PG8_SA
#undef PG8_SB
#undef PG8_STAGE
#undef PG8_LDA
#undef PG8_LDB
#undef PG8_MMA
#undef PG8_WAIT_V
#undef PG8_WAIT_L
#undef PG8_BAR
#undef PG8_SCHED
}
}
#define LAS __attribute__((address_space(3)))
typedef unsigned short bf16;
typedef float f32x4 __attribute__((ext_vector_type(4)));
typedef unsigned v4u __attribute__((ext_vector_type(4)));
typedef unsigned v2u __attribute__((ext_vector_type(2)));
typedef short bf16x8 __attribute__((ext_vector_type(8)));
constexpr int DM = 2048, SEQ = 2048, BATCH = 16, NMETA = 16, DEPTH = 2;
constexpr int DHG = 1024, DS5 = 1024, DIN = 5120, DFF = 5632;
constexpr int MMAIN = BATCH * SEQ;
constexpr int META0 = MMAIN;
constexpr int MPAD = MMAIN + 256;
constexpr int NSEGS = MPAD / 64;
constexpr float EPS = 1e-6f;
constexpr int NWAVES = 8, NTHREADS = 512;
constexpr int LDS_BYTES = 147456;
#ifndef DEFER_L1_WEIGHTS
#define DEFER_L1_WEIGHTS 1
#endif

constexpr size_t MiB = 1u << 20;
constexpr size_t WS_CTL = 0, CTL_ZERO_BYTES = 2 * MiB;
constexpr size_t WS_BAR_OFF = 1 * MiB;
constexpr size_t RS_STRIDE = MPAD;
constexpr size_t WS_S5A = 2 * MiB;
constexpr size_t WS_S5B = 2 * MiB + 128 * 1024;
constexpr size_t WS_LB = 3 * MiB + 512 * 1024;
constexpr size_t WS_HMETA = 4 * MiB;
constexpr size_t WS_METAA = 6 * MiB;
constexpr size_t WS_W = 8 * MiB, W_LAYER = 96 * MiB;
constexpr size_t W_IN = 0, W_GLU = 20 * MiB, W_OUT = 22 * MiB, W_GU = 30 * MiB, W_DN = 74 * MiB;
constexpr size_t WS_HB = 200 * MiB;
constexpr size_t WS_MIX = 329 * MiB;
constexpr size_t WS_SIDEA = WS_MIX, WS_SIDEU = WS_MIX + 48 * MiB;
constexpr size_t WS_R = 458 * MiB;
constexpr size_t PB = (size_t)MPAD * 1024 * 2;
constexpr size_t WS_Q = WS_R, WS_K = WS_R + PB, WS_V = WS_R + 2 * PB, WS_GS = WS_R + 3 * PB, WS_U = WS_R + 4 * PB, WS_LF = WS_R + 5 * PB;
constexpr size_t WS_HID = WS_R;
constexpr size_t WS_Y = WS_R + 7 * PB;
constexpr size_t WS_END = WS_R + 8 * PB;
static_assert((size_t)NSEGS * 4 * 5632 * 4 <= 48 * MiB && WS_SIDEU + (size_t)NSEGS * 2 * 5632 * 4 <= WS_R, "side buffers inside the mix region");
static_assert((size_t)MPAD * 5632 * 2 <= 7 * PB && WS_END <= 1024 * MiB, "workspace map");

__device__ __forceinline__ unsigned f2bf(float f) { unsigned u = __builtin_bit_cast(unsigned, f); return (u + 0x7fffu + ((u >> 16) & 1u)) >> 16; }
__device__ __forceinline__ unsigned pk2(float lo, float hi) { return f2bf(lo) | (f2bf(hi) << 16); }
__device__ __forceinline__ float bflo(unsigned w) { return __uint_as_float(w << 16); }
__device__ __forceinline__ float bfhi(unsigned w) { return __uint_as_float(w & 0xffff0000u); }
__device__ __forceinline__ float wave_sum(float v) {
#pragma unroll
    for (int o = 1; o < 64; o <<= 1) v += __shfl_xor(v, o);
    return v;
}
#define LDS_WAIT() asm volatile("s_waitcnt lgkmcnt(0)" ::: "memory")
#define LDS_BAR() asm volatile("s_waitcnt lgkmcnt(0)\n\ts_barrier" ::: "memory")

struct Args { const float* in[25]; float* out; unsigned char* ws; int ph_lo, ph_hi; };

__device__ __forceinline__ void transpose_item(const float* W, int K, int N, bf16* WT, int drow0, const float* kscale, LAS float* scr, int k0, int n0, int lane) {
    const int lr = lane >> 4, lc = (lane & 15) * 4;
    f32x4 v[16];
#pragma unroll
    for (int i = 0; i < 16; ++i) v[i] = *(const f32x4*)(W + (size_t)(k0 + 4 * i + lr) * N + n0 + lc);
#pragma unroll
    for (int i = 0; i < 16; ++i) { const int kk = 4 * i + lr; const float sc = kscale ? kscale[k0 + kk] : 1.0f; LAS float* p = scr + kk * 65 + lc;
        p[0] = v[i][0] * sc; p[1] = v[i][1] * sc; p[2] = v[i][2] * sc; p[3] = v[i][3] * sc; }
    LDS_WAIT(); asm volatile("" ::: "memory");
    const int c = lane & 7;
#pragma unroll
    for (int j = 0; j < 8; ++j) { const int n = (lane >> 3) + 8 * j; const LAS float* s = scr + (8 * c) * 65 + n;
        v4u o; o.x = pk2(s[0 * 65], s[1 * 65]); o.y = pk2(s[2 * 65], s[3 * 65]); o.z = pk2(s[4 * 65], s[5 * 65]); o.w = pk2(s[6 * 65], s[7 * 65]);
        *(v4u*)(WT + (size_t)(drow0 + n) * K + k0 + 8 * c) = o; }
    LDS_WAIT(); asm volatile("" ::: "memory");
}

__device__ __forceinline__ void prep_weights(const Args& a, LAS unsigned char* lds, int l, int gw, int NGW, int wave, int lane) {
    unsigned char* ws = a.ws;
    LAS float* scr = (LAS float*)(lds + wave * 16640);
    constexpr int I_IN = 32 * 80, I_GLU = 16 * 16, I_OUT = 32 * 32, I_G = 32 * 88, I_DN = 88 * 32, PER_L = I_IN + I_GLU + I_OUT + 2 * I_G + I_DN;
    unsigned char* wl = ws + WS_W + (size_t)l * W_LAYER;
    for (int it = gw; it < PER_L; it += NGW) {
        int r = it;
        if (r < I_IN) { transpose_item(a.in[4] + (size_t)l * DM * DIN, DM, DIN, (bf16*)(wl + W_IN), 64 * (r % 80), a.in[3] + l * DM, scr, 64 * (r / 80), 64 * (r % 80), lane); continue; } r -= I_IN;
        if (r < I_GLU) { transpose_item(a.in[14] + (size_t)l * DS5 * DS5, DS5, DS5, (bf16*)(wl + W_GLU), 64 * (r % 16), nullptr, scr, 64 * (r / 16), 64 * (r % 16), lane); continue; } r -= I_GLU;
        if (r < I_OUT) { transpose_item(a.in[17] + (size_t)l * DM * DM, DM, DM, (bf16*)(wl + W_OUT), 64 * (r % 32), nullptr, scr, 64 * (r / 32), 64 * (r % 32), lane); continue; } r -= I_OUT;
        if (r < 2 * I_G) { const int up = r >= I_G; if (up) r -= I_G; const int n0 = 64 * (r % 88), drow0 = 256 * (n0 / 128) + (n0 % 128) + (up ? 128 : 0);
            transpose_item(a.in[up ? 20 : 19] + (size_t)l * DM * DFF, DM, DFF, (bf16*)(wl + W_GU), drow0, a.in[18] + l * DM, scr, 64 * (r / 88), n0, lane); continue; } r -= 2 * I_G;
        transpose_item(a.in[23] + (size_t)l * DFF * DM, DFF, DM, (bf16*)(wl + W_DN), 64 * (r % 32), nullptr, scr, 64 * (r / 32), 64 * (r % 32), lane);
    }
}

__device__ __forceinline__ void p0_prologue(const Args& a, LAS unsigned char* lds) {
    int tid = threadIdx.x; asm volatile("" : "+v"(tid));
    const int lane = tid & 63, wave = tid >> 6;
    const int gw = blockIdx.x * NWAVES + wave, NGW = gridDim.x * NWAVES;
    unsigned char* ws = a.ws;
    prep_weights(a, lds, 0, gw, NGW, wave, lane);
    if (!DEFER_L1_WEIGHTS || gridDim.x != 256) prep_weights(a, lds, 1, gw, NGW, wave, lane);
    float* rs0 = (float*)(ws + WS_CTL); bf16* HB = (bf16*)(ws + WS_HB);
    for (int m = gw; m < MPAD; m += NGW) {
        const float* src = m < MMAIN ? a.in[0] + (size_t)m * DM : (m < MMAIN + NMETA ? a.in[1] + (size_t)(m - MMAIN) * DM : nullptr);
        f32x4 v[8]; float ss = 0.f;
#pragma unroll
        for (int j = 0; j < 8; ++j) { v[j] = src ? *(const f32x4*)(src + 4 * lane + 256 * j) : (f32x4){0.f, 0.f, 0.f, 0.f}; ss += (v[j][0] * v[j][0] + v[j][1] * v[j][1]) + (v[j][2] * v[j][2] + v[j][3] * v[j][3]); }
        ss = wave_sum(ss);
#pragma unroll
        for (int j = 0; j < 8; ++j) { v2u w; w.x = pk2(v[j][0], v[j][1]); w.y = pk2(v[j][2], v[j][3]); *(v2u*)(HB + (size_t)m * DM + 4 * lane + 256 * j) = w;
}
        if (lane == 0) rs0[m] = ss;
    }
    const int gt = blockIdx.x * NTHREADS + tid, NGT = gridDim.x * NTHREADS;
    float* S5A = (float*)(ws + WS_S5A); float* S5B = (float*)(ws + WS_S5B); float* LB = (float*)(ws + WS_LB);
    for (int i = gt; i < DEPTH * 64 * 64; i += NGT) {
        const int lg = i >> 6;
        const float are = fminf(a.in[6][i], -1e-4f), aim = a.in[7][i], dt = expf(a.in[8][lg]);
        const float mag = expf(are * dt), abr = mag * cosf(aim * dt), abi = mag * sinf(aim * dt);
        const float den = are * are + aim * aim, xre = abr - 1.0f, xim = abi;
        const float zre = (xre * are + xim * aim) / den, zim = (xim * are - xre * aim) / den;
        S5A[2 * i] = abr; S5A[2 * i + 1] = abi;
        for (int h = 0; h < 16; ++h) { const float br = a.in[9][(size_t)i * 16 + h], bi = a.in[10][(size_t)i * 16 + h];
            S5B[((size_t)i * 16 + h) * 2] = zre * br - zim * bi; S5B[((size_t)i * 16 + h) * 2 + 1] = zre * bi + zim * br; }
    }
    for (int i = gt; i < DHG; i += NGT) {
        const float x0 = a.in[2][i], x1 = a.in[2][DHG + i], mx = fmaxf(x0, x1), e0 = expf(x0 - mx), e1 = expf(x1 - mx), s0 = e0 / (e0 + e1), s1 = e1 / (e0 + e1);
        LB[i] = s0 - s0; LB[DHG + i] = (s0 + s1) - s0;
    }
}

typedef __bf16 bf16x2_t __attribute__((ext_vector_type(2)));
typedef float f32x2_t __attribute__((ext_vector_type(2)));
__device__ __forceinline__ unsigned cvtpk(float lo, float hi) { f32x2_t v = {lo, hi}; bf16x2_t b = __builtin_convertvector(v, bf16x2_t); return __builtin_bit_cast(unsigned, b); }
__device__ __forceinline__ bf16x8 as_frag(unsigned a, unsigned b, unsigned c, unsigned d) { v4u t; t.x = a; t.y = b; t.z = c; t.w = d; return __builtin_bit_cast(bf16x8, t); }
constexpr int HG_RAW = 20480, HG_TILE0 = 2 * HG_RAW, HG_TILE = 21760, HG_SS0 = HG_TILE0 + 2 * HG_TILE;
__device__ __forceinline__ void hg_estage(LAS unsigned char* raw, LAS unsigned char* tile, int d, int tq) {
    const LAS float* RAWG = (const LAS float*)raw; const LAS bf16* RAWQ = (const LAS bf16*)(raw + 8192); const LAS bf16* RAWK = (const LAS bf16*)(raw + 12288); const LAS bf16* RAWV = (const LAS bf16*)(raw + 16384);
    LAS bf16* QA = (LAS bf16*)tile; LAS bf16* QM = (LAS bf16*)(tile + 4352); LAS bf16* KM = (LAS bf16*)(tile + 8704); LAS bf16* KBT = (LAS bf16*)(tile + 13056); LAS bf16* VT = (LAS bf16*)(tile + 17152); LAS float* DEC = (LAS float*)(tile + 21248);
    float g[16];
#pragma unroll
    for (int t = 0; t < 16; ++t) g[t] = RAWG[t * 128 + d];
    const float s0 = (g[0] + g[1]) + (g[2] + g[3]), s1 = (g[4] + g[5]) + (g[6] + g[7]), s2 = (g[8] + g[9]) + (g[10] + g[11]), s3 = (g[12] + g[13]) + (g[14] + g[15]);
    const float b7 = s0 + s1, bl = b7 + (s2 + s3);
    float run = (tq > 0 ? s0 : 0.f) + (tq > 1 ? s1 : 0.f) + (tq > 2 ? s2 : 0.f);
    float kbv[4]; unsigned vv[4];
#pragma unroll
    for (int j = 0; j < 4; ++j) {
        const int t = 4 * tq + j;
        run += RAWG[t * 128 + d];
        const float q = __uint_as_float((unsigned)RAWQ[t * 128 + d] << 16), k = __uint_as_float((unsigned)RAWK[t * 128 + d] << 16);
        vv[j] = RAWV[t * 128 + d];
        const float qa = q * __expf(run), qm = q * __expf(fminf(run - b7, 80.f)), km = k * __expf(fminf(b7 - run, 80.f));
        kbv[j] = k * __expf(bl - run);
        QA[t * 136 + d] = (bf16)cvtpk(qa, 0.f); QM[t * 136 + d] = (bf16)cvtpk(qm, 0.f); KM[t * 136 + d] = (bf16)cvtpk(km, 0.f);
    }
    v2u kw; kw.x = cvtpk(kbv[0], kbv[1]); kw.y = cvtpk(kbv[2], kbv[3]); *(LAS v2u*)(KBT + d * 16 + 4 * tq) = kw;
    v2u vw; vw.x = vv[0] | (vv[1] << 16); vw.y = vv[2] | (vv[3] << 16); *(LAS v2u*)(VT + d * 16 + 4 * tq) = vw;
    if (tq == 0) DEC[d] = __expf(bl);
}
__device__ __forceinline__ f32x4 hg_mstage(const LAS unsigned char* tile, LAS float* SS, f32x4 (&S)[8], int w, int fr, int fq) {
    const LAS bf16* QA = (const LAS bf16*)tile; const LAS bf16* QM = (const LAS bf16*)(tile + 4352); const LAS bf16* KM = (const LAS bf16*)(tile + 8704); const LAS bf16* KBT = (const LAS bf16*)(tile + 13056); const LAS bf16* VT = (const LAS bf16*)(tile + 17152); const LAS float* DEC = (const LAS float*)(tile + 21248);
    const int e0 = 16 * w;
    f32x4 accP = {0.f, 0.f, 0.f, 0.f}, accO = {0.f, 0.f, 0.f, 0.f};
#pragma unroll
    for (int ks = 0; ks < 4; ++ks) { const bf16x8 a = *(const LAS bf16x8*)(KM + fr * 136 + 32 * ks + 8 * fq), bq = *(const LAS bf16x8*)(QM + fr * 136 + 32 * ks + 8 * fq);
        accP = __builtin_amdgcn_mfma_f32_16x16x32_bf16(a, bq, accP, 0, 0, 0); }
    float p[4];
#pragma unroll
    for (int r = 0; r < 4; ++r) p[r] = (4 * fq + r <= fr) ? accP[r] : 0.f;
    const bf16x8 pa = as_frag(cvtpk(p[0], p[1]), cvtpk(p[2], p[3]), 0u, 0u);
    const v2u vt2 = *(const LAS v2u*)(VT + (e0 + fr) * 16 + 4 * fq); const bf16x8 vb = as_frag(vt2.x, vt2.y, 0u, 0u);
#pragma unroll
    for (int ks = 0; ks < 4; ++ks) {
        const bf16x8 sb = as_frag(cvtpk(S[2 * ks][0], S[2 * ks][1]), cvtpk(S[2 * ks][2], S[2 * ks][3]), cvtpk(S[2 * ks + 1][0], S[2 * ks + 1][1]), cvtpk(S[2 * ks + 1][2], S[2 * ks + 1][3]));
        const v2u alo = *(const LAS v2u*)(QA + fr * 136 + 32 * ks + 4 * fq), ahi = *(const LAS v2u*)(QA + fr * 136 + 32 * ks + 16 + 4 * fq);
        accO = __builtin_amdgcn_mfma_f32_16x16x32_bf16(as_frag(alo.x, alo.y, ahi.x, ahi.y), sb, accO, 0, 0, 0); }
    accO = __builtin_amdgcn_mfma_f32_16x16x32_bf16(pa, vb, accO, 0, 0, 0);
#pragma unroll
    for (int T = 0; T < 8; ++T) { const f32x4 dc = *(const LAS f32x4*)(DEC + 16 * T + 4 * fq); S[T] = S[T] * dc;
        const v2u kk = *(const LAS v2u*)(KBT + (16 * T + fr) * 16 + 4 * fq);
        S[T] = __builtin_amdgcn_mfma_f32_16x16x32_bf16(as_frag(kk.x, kk.y, 0u, 0u), vb, S[T], 0, 0, 0); }
    f32x4 sq = accO * accO;
#pragma unroll
    for (int x = 1; x < 16; x <<= 1) { sq[0] += __shfl_xor(sq[0], x); sq[1] += __shfl_xor(sq[1], x); sq[2] += __shfl_xor(sq[2], x); sq[3] += __shfl_xor(sq[3], x); }
    if (fr == 0) *(LAS f32x4*)(SS + w * 16 + 4 * fq) = sq;
    return accO;
}
__device__ __forceinline__ void hgrn2_item(LAS unsigned char* lds, const int tid, int b, int h, const bf16* Q, const bf16* Kb, const float* LF, const bf16* V, const bf16* GS, bf16* MIX, const float* gain) {
    const int lane = tid & 63, w = __builtin_amdgcn_readfirstlane(tid >> 6), fr = lane & 15, fq = lane >> 4, e0 = 16 * w;
    const int d = tid & 127, tq = __builtin_amdgcn_readfirstlane(tid >> 7);
    const int gt = tid >> 5, gd = (tid & 31) * 4, bt = (tid & 255) >> 4, bd = (tid & 15) * 8;
    const bool lowhalf = tid < 256;
    const bf16* src0 = lowhalf ? Q : Kb; const int raw0off = lowhalf ? 8192 : 12288;
    f32x4 rg; v4u r0, r1 = {0u, 0u, 0u, 0u};
    f32x4 S[8];
#pragma unroll
    for (int T = 0; T < 8; ++T) S[T] = (f32x4){0.f, 0.f, 0.f, 0.f};
    const float gn = gain[h * 128 + e0 + fr];
#define HG_ROW0(c) ((c) == 0 ? META0 : b * SEQ + 16 * ((c) - 1))
#define HG_L(c) do { const int rn_ = HG_ROW0(c); const size_t go_ = (size_t)(rn_ + gt) * 1024 + h * 128 + gd, bo_ = (size_t)(rn_ + bt) * 1024 + h * 128 + bd; \
        rg = *(const f32x4*)(LF + go_); r0 = *(const v4u*)(src0 + bo_); if (lowhalf) r1 = *(const v4u*)(V + bo_); } while (0)
#define HG_W(c) do { LAS unsigned char* raw_ = lds + ((c) & 1) * HG_RAW; *(LAS f32x4*)(raw_ + (gt * 128 + gd) * 4) = rg; *(LAS v4u*)(raw_ + raw0off + (bt * 128 + bd) * 2) = r0; \
        if (lowhalf) *(LAS v4u*)(raw_ + 16384 + (bt * 128 + bd) * 2) = r1; } while (0)
    HG_L(0);
    HG_W(0); HG_L(1);
    LDS_BAR();
    hg_estage(lds, lds + HG_TILE0, d, tq); HG_W(1); HG_L(2);
    LDS_BAR();
    f32x4 oprev = {0.f, 0.f, 0.f, 0.f}; unsigned short gprev[4] = {0, 0, 0, 0};
    for (int i = 0; i <= 128; ++i) {
        if (i > 0 && (i > 1 || b == 0)) {
            const int row0 = HG_ROW0(i - 1); const LAS float* SSp = (const LAS float*)(lds + HG_SS0 + ((i - 1) & 1) * 512);
            f32x4 tot = {0.f, 0.f, 0.f, 0.f};
#pragma unroll
            for (int ww = 0; ww < 8; ++ww) tot += *(const LAS f32x4*)(SSp + ww * 16 + 4 * fq);
#pragma unroll
            for (int r = 0; r < 4; ++r) { const float rstd = rsqrtf(tot[r] * (1.0f / 128.0f) + EPS);
                MIX[(size_t)(row0 + 4 * fq + r) * 2048 + h * 128 + e0 + fr] = (bf16)cvtpk(oprev[r] * rstd * gn * __uint_as_float((unsigned)gprev[r] << 16), 0.f); }
        }
        if (i + 2 <= 128) HG_W(i + 2);
        if (i + 3 <= 128) HG_L(i + 3);
        { const int row0 = HG_ROW0(i);
#pragma unroll
          for (int r = 0; r < 4; ++r) gprev[r] = GS[(size_t)(row0 + 4 * fq + r) * 1024 + h * 128 + e0 + fr]; }
        hg_estage(lds + ((i + 1) & 1) * HG_RAW, lds + HG_TILE0 + ((i + 1) & 1) * HG_TILE, d, tq);
        oprev = hg_mstage(lds + HG_TILE0 + (i & 1) * HG_TILE, (LAS float*)(lds + HG_SS0 + (i & 1) * 512), S, w, fr, fq);
        LDS_BAR();
    }
    {
        const int row0 = HG_ROW0(128); const LAS float* SSp = (const LAS float*)(lds + HG_SS0);
        f32x4 tot = {0.f, 0.f, 0.f, 0.f};
#pragma unroll
        for (int ww = 0; ww < 8; ++ww) tot += *(const LAS f32x4*)(SSp + ww * 16 + 4 * fq);
#pragma unroll
        for (int r = 0; r < 4; ++r) { const float rstd = rsqrtf(tot[r] * (1.0f / 128.0f) + EPS);
            MIX[(size_t)(row0 + 4 * fq + r) * 2048 + h * 128 + e0 + fr] = (bf16)cvtpk(oprev[r] * rstd * gn * __uint_as_float((unsigned)gprev[r] << 16), 0.f); }
    }
#undef HG_ROW0
#undef HG_L
#undef HG_W
    __syncthreads();
}

__device__ __forceinline__ void s5_item(LAS unsigned char* ldsw, int b, int g, int lane, const bf16* UY, bf16* YO, const float* S5A, const float* S5B, const float* cre, const float* cim, const float* dsk) {
    LAS bf16* Xs = (LAS bf16*)ldsw;
    LAS float* Us = (LAS float*)(ldsw + 4352);
    LAS float* BuT = (LAS float*)(ldsw + 5376);
    const int p = lane, fr = lane & 15, fq = lane >> 4;
    const float ar = S5A[(g * 64 + p) * 2], ai = S5A[(g * 64 + p) * 2 + 1];
    bf16x8 bfr[8], cf[4];
#pragma unroll
    for (int nt = 0; nt < 8; ++nt) { const int col = 16 * nt + fr, pp = col & 63, part = col >> 6;
#pragma unroll
        for (int j = 0; j < 8; ++j) { const float val = fq < 2 ? S5B[((size_t)(g * 64 + pp) * 16 + 8 * fq + j) * 2 + part] : 0.f; bfr[nt][j] = (short)f2bf(val); } }
#pragma unroll
    for (int ks = 0; ks < 4; ++ks)
#pragma unroll
        for (int j = 0; j < 8; ++j) { const int k = 32 * ks + 8 * fq + j; const float val = k < 64 ? cre[(size_t)(g * 16 + fr) * 64 + k] : -cim[(size_t)(g * 16 + fr) * 64 + (k - 64)]; cf[ks][j] = (short)f2bf(val); }
    const float dv = dsk[g * 16 + fr];
    float xr = 0.f, xi = 0.f;
    const int ucol = g * 16 + 8 * (fq & 1);
    v4u ru = {0u, 0u, 0u, 0u};
    if (fq < 2) ru = *(const v4u*)(UY + (size_t)(META0 + fr) * 1024 + ucol);
    for (int c = 0; c <= 128; ++c) {
        const int row0 = c == 0 ? META0 : b * SEQ + 16 * (c - 1);
        const bf16x8 ua = __builtin_bit_cast(bf16x8, ru);
        if (fq < 2) { LAS float* q = Us + fr * 16 + 8 * fq; *(LAS f32x4*)q = (f32x4){bflo(ru.x), bfhi(ru.x), bflo(ru.y), bfhi(ru.y)}; *(LAS f32x4*)(q + 4) = (f32x4){bflo(ru.z), bfhi(ru.z), bflo(ru.w), bfhi(ru.w)}; }
        if (c < 128 && fq < 2) ru = *(const v4u*)(UY + (size_t)(b * SEQ + 16 * c + fr) * 1024 + ucol);
#pragma unroll
        for (int nt = 0; nt < 8; ++nt) { f32x4 acc = {0.f, 0.f, 0.f, 0.f}; acc = __builtin_amdgcn_mfma_f32_16x16x32_bf16(ua, bfr[nt], acc, 0, 0, 0);
#pragma unroll
            for (int r = 0; r < 4; ++r) BuT[(4 * fq + r) * 132 + 16 * nt + fr] = acc[r]; }
        LDS_WAIT(); asm volatile("" ::: "memory");
#pragma unroll
        for (int t = 0; t < 16; ++t) {
            const float bur = BuT[t * 132 + p], bui = BuT[t * 132 + 64 + p];
            const float nxr = ar * xr - ai * xi + bur, nxi = ar * xi + ai * xr + bui; xr = nxr; xi = nxi;
            Xs[t * 136 + p] = (bf16)f2bf(xr); Xs[t * 136 + 64 + p] = (bf16)f2bf(xi);
        }
        LDS_WAIT(); asm volatile("" ::: "memory");
        f32x4 acc = {0.f, 0.f, 0.f, 0.f};
#pragma unroll
        for (int ks = 0; ks < 4; ++ks) { const bf16x8 af = *(const LAS bf16x8*)(Xs + fr * 136 + 32 * ks + 8 * fq); acc = __builtin_amdgcn_mfma_f32_16x16x32_bf16(af, cf[ks], acc, 0, 0, 0); }
#pragma unroll
        for (int r = 0; r < 4; ++r) { const int t = 4 * fq + r; const float uu = Us[t * 16 + fr]; float y = acc[r] + dv * uu;
            const float in = 1.5957691216f * (y + 0.044715f * y * y * y); y = y * __builtin_amdgcn_rcpf(1.0f + __expf(-in));
            if (c > 0 || b == 0) YO[(size_t)(row0 + t) * 1024 + g * 16 + fr] = (bf16)f2bf(y); }
        LDS_WAIT(); asm volatile("" ::: "memory");
    }
}

__device__ __forceinline__ f32x4 meta_kloop(const bf16* W, const bf16* X, int K, int wave, int fr, int fq) {
    f32x4 acc = {0.f, 0.f, 0.f, 0.f};
    const bf16* wp = W + (size_t)fr * K + 8 * fq; const bf16* xp = X + (size_t)fr * K + 8 * fq;
    const int nks = K >> 5;
#pragma unroll 4
    for (int ks = wave; ks < nks; ks += 8) { const bf16x8 a = *(const bf16x8*)(wp + 32 * ks), b = *(const bf16x8*)(xp + 32 * ks); acc = __builtin_amdgcn_mfma_f32_16x16x32_bf16(a, b, acc, 0, 0, 0); }
    return acc;
}
__device__ __forceinline__ f32x4 meta_reduce(LAS float* red, f32x4 acc, int wave, int lane) {
    *(LAS f32x4*)(red + (wave * 64 + lane) * 4) = acc;
    __syncthreads();
    f32x4 s = {0.f, 0.f, 0.f, 0.f};
    if (wave == 0) {
#pragma unroll
        for (int w = 0; w < 8; ++w) s += *(const LAS f32x4*)(red + (w * 64 + lane) * 4);
    }
    __syncthreads();
    return s;
}
struct MetaP { const bf16* W; const bf16* X; int N, K; const float* rs; const float* lb; bf16* Q; bf16* Kb; float* LF; bf16* V; bf16* GS; bf16* U;
               const bf16* Y; const float* bias; bf16* MIX; float* rsacc; float* hmeta; bf16* HB; bf16* Hd; const float* cw; const float* cb; float* metaA; };
template <int MODE> __device__ __forceinline__ void meta_gemm(LAS unsigned char* lds, const MetaP& P) {
    int tid = threadIdx.x; asm volatile("" : "+v"(tid));
    const int lane = tid & 63, wave = __builtin_amdgcn_readfirstlane(tid >> 6), fr = lane & 15, fq = lane >> 4;
    LAS float* red = (LAS float*)lds; LAS float* red2 = red + 2048;
    const int ntiles = (MODE == 3 ? DFF : P.N) / 16, row = META0 + fr;
    for (int nt = blockIdx.x; nt < ntiles; nt += gridDim.x) {
        const int n0 = 16 * nt;
        if (MODE == 3) {
            const int grow = 256 * (n0 >> 7) + (n0 & 127);
            f32x4 ag = meta_kloop(P.W + (size_t)grow * P.K, P.X, P.K, wave, fr, fq), au = meta_kloop(P.W + (size_t)(grow + 128) * P.K, P.X, P.K, wave, fr, fq);
            ag = meta_reduce(red, ag, wave, lane); au = meta_reduce(red2, au, wave, lane);
            if (wave == 0) {
                const float rstd = rsqrtf(P.rs[row] * (1.0f / 2048.0f) + EPS); const int f = n0 + 4 * fq;
                const f32x4 a = ag * rstd, up = au * rstd;
                f32x4 p1, p2;
#pragma unroll
                for (int r = 0; r < 4; ++r) { const float s1 = __shfl(a[r], (lane - 1) & 63), s2 = __shfl(a[r], (lane - 2) & 63); p1[r] = fr >= 1 ? s1 : 0.f; p2[r] = fr >= 2 ? s2 : 0.f; }
                const f32x4 w0 = *(const f32x4*)(P.cw + f), w1 = *(const f32x4*)(P.cw + DFF + f), w2 = *(const f32x4*)(P.cw + 2 * DFF + f), bb = *(const f32x4*)(P.cb + f);
                const f32x4 cv = bb + w0 * p2 + w1 * p1 + w2 * a;
                v2u w; w.x = cvtpk(pg8::silu_f(cv[0]) * up[0], pg8::silu_f(cv[1]) * up[1]); w.y = cvtpk(pg8::silu_f(cv[2]) * up[2], pg8::silu_f(cv[3]) * up[3]);
                *(v2u*)(P.Hd + (size_t)row * DFF + f) = w;
                if (fr >= 14) *(f32x4*)(P.metaA + (size_t)(fr - 14) * DFF + f) = a;
            }
        } else {
            f32x4 acc = meta_kloop(P.W + (size_t)n0 * P.K, P.X, P.K, wave, fr, fq);
            acc = meta_reduce(red, acc, wave, lane);
            if (wave == 0) {
                if (MODE == 0) {
                    const int seg = n0 >> 10, c = (n0 & 1023) + 4 * fq; const size_t off = (size_t)row * 1024 + c;
                    const float rstd = rsqrtf(P.rs[row] * (1.0f / 2048.0f) + EPS);
                    f32x4 v = acc * rstd;
                    if (seg == 1) { const f32x4 l = *(const f32x4*)(P.lb + c); f32x4 kk, lf; float tk, tf;
                        pg8::EpiIn::fgate(v[0], l[0], tk, tf); kk[0] = tk; lf[0] = tf; pg8::EpiIn::fgate(v[1], l[1], tk, tf); kk[1] = tk; lf[1] = tf;
                        pg8::EpiIn::fgate(v[2], l[2], tk, tf); kk[2] = tk; lf[2] = tf; pg8::EpiIn::fgate(v[3], l[3], tk, tf); kk[3] = tk; lf[3] = tf;
                        *(f32x4*)(P.LF + off) = lf; v = kk; }
                    else if (seg == 0 || seg == 3) v = (f32x4){pg8::silu_f(v[0]), pg8::silu_f(v[1]), pg8::silu_f(v[2]), pg8::silu_f(v[3])};
                    bf16* dst = seg == 0 ? P.Q : (seg == 1 ? P.Kb : (seg == 2 ? P.V : (seg == 3 ? P.GS : P.U)));
                    v2u w; w.x = cvtpk(v[0], v[1]); w.y = cvtpk(v[2], v[3]); *(v2u*)(dst + off) = w;
                } else if (MODE == 1) {
                    const int c = n0 + 4 * fq; const v2u yw = *(const v2u*)(P.Y + (size_t)row * 1024 + c); const f32x4 b4 = *(const f32x4*)(P.bias + c);
                    const f32x4 y = {bflo(yw.x), bfhi(yw.x), bflo(yw.y), bfhi(yw.y)}; f32x4 o;
#pragma unroll
                    for (int r = 0; r < 4; ++r) o[r] = y[r] * pg8::sigmoid_f(acc[r] + b4[r]);
                    v2u w; w.x = cvtpk(o[0], o[1]); w.y = cvtpk(o[2], o[3]); *(v2u*)(P.MIX + (size_t)row * 2048 + 1024 + c) = w;
                    float ss = (o[0] * o[0] + o[1] * o[1]) + (o[2] * o[2] + o[3] * o[3]); ss += __shfl_xor(ss, 16); ss += __shfl_xor(ss, 32);
                    if (fq == 0) atomicAdd(P.rsacc + row, ss);
                } else {
                    const int c = n0 + 4 * fq; bf16* hp = P.HB + (size_t)row * 2048 + c; const v2u hw = *(const v2u*)hp;
                    const f32x4 o = (f32x4){bflo(hw.x), bfhi(hw.x), bflo(hw.y), bfhi(hw.y)} + acc;
                    v2u w; w.x = cvtpk(o[0], o[1]); w.y = cvtpk(o[2], o[3]); *(v2u*)hp = w;
                    float ss = (o[0] * o[0] + o[1] * o[1]) + (o[2] * o[2] + o[3] * o[3]); ss += __shfl_xor(ss, 16); ss += __shfl_xor(ss, 32);
                    if (fq == 0) atomicAdd(P.rsacc + row, ss);
                }
            }
        }
    }
    __syncthreads();
}
#define XB_TMO      128
#define XB_XCNT(j)  (256  + 64 * (j))
#define XB_XSUB(j)  (1280 + 64 * (j))
#define XB_XGEN(j)  (2304 + 64 * (j))
#define XB_TOP      3328
#define XB_TOPGEN   3392
#define XCD_BAR_WORDS 3456
#define XB_SPIN_CAP (1u << 18)

__device__ __forceinline__ unsigned xb_ld(unsigned* p)              { return __hip_atomic_load(p, __ATOMIC_RELAXED, __HIP_MEMORY_SCOPE_AGENT); }
__device__ __forceinline__ unsigned xb_add(unsigned* p, unsigned v) { return __hip_atomic_fetch_add(p, v, __ATOMIC_RELAXED, __HIP_MEMORY_SCOPE_AGENT); }
__device__ __forceinline__ unsigned xb_xcc_id() { return (unsigned)__builtin_amdgcn_s_getreg((3 << 11) | 20) & 0xFu; }
#define XB_SPIN(cond, bar) do { unsigned _sp = 0; while (cond) { __builtin_amdgcn_s_sleep(1); \
    if ((++_sp & 255u) == 0u) { if (xb_ld(&(bar)[XB_TMO])) break; if (_sp > XB_SPIN_CAP) { atomicAdd(&(bar)[XB_TMO], 1u); break; } } } } while (0)

struct XcdBarrier {
    unsigned* bar; unsigned x;
    volatile LAS unsigned* st;
};

__device__ __forceinline__ XcdBarrier xcd_barrier_post(unsigned* bar, volatile LAS unsigned* st) {
    XcdBarrier b; b.bar = bar; b.x = xb_xcc_id(); b.st = st;
    if (threadIdx.x == 0) (void)xb_add(&bar[XB_XCNT(b.x)], 1u);
    return b;
}
__device__ __forceinline__ void xcd_barrier_complete(unsigned* bar, unsigned x, unsigned& nloc, unsigned& nx) {
    const unsigned G = gridDim.x * gridDim.y * gridDim.z;
    unsigned sum, cnt, mine, sp = 0u;
    for (;;) {
        sum = 0u; cnt = 0u; mine = 0u;
#pragma unroll
        for (unsigned j = 0; j < 16; ++j) { const unsigned c = xb_ld(&bar[XB_XCNT(j)]); sum += c; cnt += (c > 0u) ? 1u : 0u; mine = (j == x) ? c : mine; }
        if (sum == G) break;
        __builtin_amdgcn_s_sleep(1);
        if ((++sp & 255u) == 0u) { if (xb_ld(&bar[XB_TMO])) break; if (sp > XB_SPIN_CAP) { atomicAdd(&bar[XB_TMO], 1u); break; } }
    }
    nloc = mine > 0u ? mine : 1u; nx = cnt > 0u ? cnt : 1u;
}

__device__ __forceinline__ void xcd_barrier(const XcdBarrier& b) {
    asm volatile("s_waitcnt vmcnt(0)" ::: "memory");
    __syncthreads();
    if (threadIdx.x == 0) {
        unsigned* bar = b.bar;
        __builtin_amdgcn_s_waitcnt(0);
        unsigned nloc = b.st[0], nx = b.st[1];
        if (nloc == 0u) { xcd_barrier_complete(bar, b.x, nloc, nx); b.st[0] = nloc; b.st[1] = nx; }
        const unsigned old = xb_add(&bar[XB_XSUB(b.x)], 1u);
        const unsigned gen = old / nloc;
        if (old + 1u == (gen + 1u) * nloc) {
            __builtin_amdgcn_fence(__ATOMIC_RELEASE, "agent");
            asm volatile("s_waitcnt vmcnt(0)" ::: "memory");
            const unsigned og = xb_add(&bar[XB_TOP], 1u);
            const unsigned tg = og / nx;
            if (og + 1u == (tg + 1u) * nx) xb_add(&bar[XB_TOPGEN], 1u);
            else XB_SPIN(xb_ld(&bar[XB_TOPGEN]) == tg, bar);
            __builtin_amdgcn_fence(__ATOMIC_ACQUIRE, "agent");
            xb_add(&bar[XB_XGEN(b.x)], 1u);
            asm volatile("s_waitcnt vmcnt(0)" ::: "memory");
        } else {
            XB_SPIN(xb_ld(&bar[XB_XGEN(b.x)]) == gen, bar);
            __builtin_amdgcn_fence(__ATOMIC_ACQUIRE, "agent");
            asm volatile("s_waitcnt vmcnt(0)" ::: "memory");
        }
    }
    __syncthreads();
}
#ifndef ONE_LAUNCH
#define ONE_LAUNCH 1
#endif
#ifndef ONLY
#define ONLY -1
#endif
#define PH_ON(k) (ONLY == -1 || ONLY == (k))
#ifndef REP_MIX
#define REP_MIX 1
#endif
#ifndef REP_HG
#define REP_HG 1
#endif
#ifndef REP_S5
#define REP_S5 1
#endif
#ifndef REP_P5
#define REP_P5 1
#endif
#ifndef REP_P1
#define REP_P1 1
#endif
#ifndef REP_P0
#define REP_P0 1
#endif
constexpr int NPHASES = 18;

#define IN(k) (lo <= (k) && (k) < hi)
#define SEAM(k) do { if (IN(k) && IN((k) + 1)) { if ((k) == 0) cg::this_grid().sync(); else xcd_barrier(xbar); } } while (0)

template <int L> __device__ __forceinline__ void layer_phases(const Args& args, LAS unsigned char* lds, const int lo, const int hi, const XcdBarrier& xbar) {
    constexpr int P = 1 + 8 * L;
    unsigned char* const ws = args.ws;
    const int G = gridDim.x;
    if (IN(P + 0) && PH_ON(0)) {
        unsigned char* wl = ws + WS_W + (size_t)L * W_LAYER; float* RS = (float*)(ws + WS_CTL);
        { MetaP mp{}; mp.W = (const bf16*)(wl + W_IN); mp.X = (const bf16*)(ws + WS_HB) + (size_t)META0 * DM; mp.N = DIN; mp.K = DM; mp.rs = RS + (2 * L) * RS_STRIDE; mp.lb = (const float*)(ws + WS_LB) + L * DHG;
          mp.Q = (bf16*)(ws + WS_Q); mp.Kb = (bf16*)(ws + WS_K); mp.LF = (float*)(ws + WS_LF); mp.V = (bf16*)(ws + WS_V); mp.GS = (bf16*)(ws + WS_GS); mp.U = (bf16*)(ws + WS_U); meta_gemm<0>(lds, mp); }
        pg8::Gemm g{(const bf16*)(ws + WS_HB), (const bf16*)(wl + W_IN), MMAIN, DIN, DM}; pg8::StaticOrder S; S.init(MMAIN, DIN, G, (int)blockIdx.x);
        pg8::EpiIn E{RS + (2 * L) * RS_STRIDE, (const float*)(ws + WS_LB) + L * DHG, (bf16*)(ws + WS_Q), (bf16*)(ws + WS_K), (float*)(ws + WS_LF), (bf16*)(ws + WS_V), (bf16*)(ws + WS_GS), (bf16*)(ws + WS_U)};
        for (int rep = 0; rep < REP_P1; ++rep) pg8::gemm_phase<pg8::EpiIn, pg8::StaticOrder, true, true>(lds, g, S, E);
    }
    SEAM(P + 0);
    if (IN(P + 1) && PH_ON(1)) {
        int tid = threadIdx.x; asm volatile("" : "+v"(tid));
        const int lane = tid & 63, wave = __builtin_amdgcn_readfirstlane(tid >> 6);
        for (int rep = 0; rep < REP_MIX; ++rep)
        for (int it = blockIdx.x; it < 256; it += G) {
            if (it < 128) for (int r2 = 0; r2 < REP_HG; ++r2) hgrn2_item(lds, tid, it >> 3, it & 7, (const bf16*)(ws + WS_Q), (const bf16*)(ws + WS_K), (const float*)(ws + WS_LF), (const bf16*)(ws + WS_V), (const bf16*)(ws + WS_GS), (bf16*)(ws + WS_MIX), args.in[5] + L * DHG);
            else { const int idx = (it - 128) * 8 + wave;
                for (int r2 = 0; r2 < REP_S5; ++r2) s5_item(lds + wave * 14336, idx >> 6, idx & 63, lane, (const bf16*)(ws + WS_U), (bf16*)(ws + WS_Y), (const float*)(ws + WS_S5A) + L * 64 * 64 * 2, (const float*)(ws + WS_S5B) + (size_t)L * 64 * 64 * 32,
                        args.in[11] + (size_t)L * 64 * 16 * 64, args.in[12] + (size_t)L * 64 * 16 * 64, args.in[13] + L * DS5);
                __syncthreads(); }
        }
        if (DEFER_L1_WEIGHTS && L == 0 && G == 256 && blockIdx.x >= 128) {
            int t2 = threadIdx.x; asm volatile("" : "+v"(t2));
            prep_weights(args, lds, 1, ((int)blockIdx.x - 128) * NWAVES + (t2 >> 6), 128 * NWAVES, t2 >> 6, t2 & 63); __syncthreads(); }
    }
    SEAM(P + 1);
    if (IN(P + 2) && PH_ON(2)) {
        unsigned char* wl = ws + WS_W + (size_t)L * W_LAYER; float* RS = (float*)(ws + WS_CTL);
        { MetaP mp{}; mp.W = (const bf16*)(wl + W_GLU); mp.X = (const bf16*)(ws + WS_Y) + (size_t)META0 * DS5; mp.N = DS5; mp.K = DS5; mp.Y = (const bf16*)(ws + WS_Y); mp.bias = args.in[15] + L * DS5; mp.MIX = (bf16*)(ws + WS_MIX); mp.rsacc = RS + (5 + L) * RS_STRIDE; meta_gemm<1>(lds, mp); }
        pg8::Gemm g{(const bf16*)(ws + WS_Y), (const bf16*)(wl + W_GLU), MMAIN, DS5, DS5}; pg8::StaticOrder S; S.init(MMAIN, DS5, G, (int)blockIdx.x);
        pg8::EpiGlu E{(const bf16*)(ws + WS_Y), args.in[15] + L * DS5, (bf16*)(ws + WS_MIX), RS + (5 + L) * RS_STRIDE};
        pg8::gemm_phase<pg8::EpiGlu, pg8::StaticOrder, true, true>(lds, g, S, E);
    }
    SEAM(P + 2);
    if (IN(P + 3) && PH_ON(3)) {
        int tid = threadIdx.x; asm volatile("" : "+v"(tid));
        const int lane = tid & 63, wave = tid >> 6;
        const int gw = blockIdx.x * NWAVES + wave, NGW = G * NWAVES; const float* rs = (const float*)(ws + WS_CTL) + (5 + L) * RS_STRIDE; const float* gn = args.in[16] + L * DS5; bf16* MIX = (bf16*)(ws + WS_MIX);
        for (int m = gw; m < MMAIN + NMETA; m += NGW) {
            const float rstd = rsqrtf(rs[m] * (1.0f / 1024.0f) + EPS);
#pragma unroll
            for (int j = 0; j < 2; ++j) { bf16* p = MIX + (size_t)m * 2048 + 1024 + 8 * lane + 512 * j; const v4u w = *(const v4u*)p;
                const f32x4 g0 = *(const f32x4*)(gn + 8 * lane + 512 * j), g1 = *(const f32x4*)(gn + 8 * lane + 512 * j + 4);
                v4u o; o.x = pk2(bflo(w.x) * rstd * g0[0], bfhi(w.x) * rstd * g0[1]); o.y = pk2(bflo(w.y) * rstd * g0[2], bfhi(w.y) * rstd * g0[3]);
                o.z = pk2(bflo(w.z) * rstd * g1[0], bfhi(w.z) * rstd * g1[1]); o.w = pk2(bflo(w.w) * rstd * g1[2], bfhi(w.w) * rstd * g1[3]); *(v4u*)p = o; }
        }
    }
    SEAM(P + 3);
    if (IN(P + 4) && PH_ON(4)) {
        unsigned char* wl = ws + WS_W + (size_t)L * W_LAYER; float* RS = (float*)(ws + WS_CTL);
        { MetaP mp{}; mp.W = (const bf16*)(wl + W_OUT); mp.X = (const bf16*)(ws + WS_MIX) + (size_t)META0 * DM; mp.N = DM; mp.K = DM; mp.rsacc = RS + (2 * L + 1) * RS_STRIDE; mp.hmeta = (float*)(ws + WS_HMETA); mp.HB = (bf16*)(ws + WS_HB); meta_gemm<2>(lds, mp); }
        pg8::Gemm g{(const bf16*)(ws + WS_MIX), (const bf16*)(wl + W_OUT), MMAIN, DM, DM}; pg8::StaticOrder S; S.init(MMAIN, DM, G, (int)blockIdx.x);
        pg8::EpiRes E{nullptr, (bf16*)(ws + WS_HB), RS + (2 * L + 1) * RS_STRIDE};
        pg8::gemm_phase<pg8::EpiRes, pg8::StaticOrder, true, true>(lds, g, S, E);
    }
    SEAM(P + 4);
    if (IN(P + 5) && PH_ON(5)) {
        unsigned char* wl = ws + WS_W + (size_t)L * W_LAYER; float* RS = (float*)(ws + WS_CTL);
        { MetaP mp{}; mp.W = (const bf16*)(wl + W_GU); mp.X = (const bf16*)(ws + WS_HB) + (size_t)META0 * DM; mp.N = 2 * DFF; mp.K = DM; mp.rs = RS + (2 * L + 1) * RS_STRIDE; mp.Hd = (bf16*)(ws + WS_HID); mp.cw = args.in[21] + (size_t)L * 3 * DFF; mp.cb = args.in[22] + L * DFF; mp.metaA = (float*)(ws + WS_METAA); meta_gemm<3>(lds, mp); }
        pg8::Gemm g{(const bf16*)(ws + WS_HB), (const bf16*)(wl + W_GU), MMAIN, 2 * DFF, DM}; pg8::StaticOrder S; S.init(MMAIN, 2 * DFF, G, (int)blockIdx.x);
        pg8::EpiGU E{RS + (2 * L + 1) * RS_STRIDE, (bf16*)(ws + WS_HID), args.in[21] + (size_t)L * 3 * DFF, args.in[22] + L * DFF, (float*)(ws + WS_SIDEA), (float*)(ws + WS_SIDEU), (float*)(ws + WS_METAA)};
        for (int rep = 0; rep < REP_P5; ++rep) pg8::gemm_phase<pg8::EpiGU, pg8::StaticOrder, true, true>(lds, g, S, E);
    }
    SEAM(P + 5);
    if (IN(P + 6) && PH_ON(6)) {
        int tid = threadIdx.x; asm volatile("" : "+v"(tid));
        const float* cw = args.in[21] + (size_t)L * 3 * DFF; const float* cb = args.in[22] + L * DFF;
        const float* sideA = (const float*)(ws + WS_SIDEA); const float* sideU = (const float*)(ws + WS_SIDEU); const float* metaA = (const float*)(ws + WS_METAA); bf16* HID = (bf16*)(ws + WS_HID);
        const int gt = blockIdx.x * NTHREADS + tid, NGT = G * NTHREADS; constexpr int F4 = DFF / 4;
        for (int i = gt; i < 512 * 2 * F4; i += NGT) {
            const int f = (i % F4) * 4, sr = i / F4, r = sr & 1, seg = sr >> 1;
            const f32x4 a0 = *(const f32x4*)(sideA + (size_t)(seg * 4 + 0) * DFF + f), a1 = *(const f32x4*)(sideA + (size_t)(seg * 4 + 1) * DFF + f);
            f32x4 h0, h1;
            if ((seg & 31) == 0) { h0 = *(const f32x4*)(metaA + f); h1 = *(const f32x4*)(metaA + DFF + f); }
            else { h0 = *(const f32x4*)(sideA + (size_t)((seg - 1) * 4 + 2) * DFF + f); h1 = *(const f32x4*)(sideA + (size_t)((seg - 1) * 4 + 3) * DFF + f); }
            const f32x4 cur = r ? a1 : a0, p1 = r ? a0 : h1, p2 = r ? h1 : h0;
            const f32x4 w0 = *(const f32x4*)(cw + f), w1 = *(const f32x4*)(cw + DFF + f), w2 = *(const f32x4*)(cw + 2 * DFF + f), bb = *(const f32x4*)(cb + f);
            const f32x4 up = *(const f32x4*)(sideU + (size_t)(seg * 2 + r) * DFF + f);
            const f32x4 cv = bb + w0 * p2 + w1 * p1 + w2 * cur;
            v2u w; w.x = pk2(pg8::silu_f(cv[0]) * up[0], pg8::silu_f(cv[1]) * up[1]); w.y = pk2(pg8::silu_f(cv[2]) * up[2], pg8::silu_f(cv[3]) * up[3]);
            *(v2u*)(HID + (size_t)(seg * 64 + r) * DFF + f) = w;
        }
    }
    SEAM(P + 6);
    if (IN(P + 7) && PH_ON(7)) {
        unsigned char* wl = ws + WS_W + (size_t)L * W_LAYER; float* RS = (float*)(ws + WS_CTL);
        { MetaP mp{}; mp.W = (const bf16*)(wl + W_DN); mp.X = (const bf16*)(ws + WS_HID) + (size_t)META0 * DFF; mp.N = DM; mp.K = DFF; mp.rsacc = RS + (2 * L + 2) * RS_STRIDE; mp.hmeta = (float*)(ws + WS_HMETA); mp.HB = (bf16*)(ws + WS_HB); meta_gemm<2>(lds, mp); }
        pg8::Gemm g{(const bf16*)(ws + WS_HID), (const bf16*)(wl + W_DN), MMAIN, DM, DFF}; pg8::StaticOrder S; S.init(MMAIN, DM, G, (int)blockIdx.x);
        pg8::EpiRes E{L == DEPTH - 1 ? args.out : nullptr, (bf16*)(ws + WS_HB), RS + (2 * L + 2) * RS_STRIDE};
        pg8::gemm_phase<pg8::EpiRes, pg8::StaticOrder, true, true>(lds, g, S, E);
    }
    SEAM(P + 7);
}

__global__ void __launch_bounds__(NTHREADS) fwd_kernel(Args args) {
    extern __shared__ __attribute__((aligned(16))) unsigned char lds_raw[];
    LAS unsigned char* lds = (LAS unsigned char*)lds_raw;
    const int lo = args.ph_lo, hi = args.ph_hi;
    volatile LAS unsigned* xst = (volatile LAS unsigned*)(lds + LDS_BYTES - 64);
    if (threadIdx.x < 2) xst[threadIdx.x] = 0u;
    __syncthreads();
    const XcdBarrier xbar = xcd_barrier_post((unsigned*)(args.ws + WS_CTL + WS_BAR_OFF), xst);
    if (IN(0) && PH_ON(100)) { for (int rep = 0; rep < REP_P0; ++rep) p0_prologue(args, lds); }
    SEAM(0);
    layer_phases<0>(args, lds, lo, hi, xbar);
    layer_phases<1>(args, lds, lo, hi, xbar);
    if (IN(NPHASES - 1) && PH_ON(101)) {
        int tid = threadIdx.x; asm volatile("" : "+v"(tid));
        const int lane = tid & 63, wave = tid >> 6;
        const int gw = blockIdx.x * NWAVES + wave, NGW = gridDim.x * NWAVES; const float* rs = (const float*)(args.ws + WS_CTL) + 4 * RS_STRIDE; const float* gn = args.in[24];
        for (int m = gw; m < MMAIN; m += NGW) {
            const float rstd = rsqrtf(rs[m] * (1.0f / 2048.0f) + EPS); float* row = args.out + (size_t)m * DM;
#pragma unroll
            for (int j = 0; j < 8; ++j) { const f32x4 v = *(const f32x4*)(row + 4 * lane + 256 * j), g4 = *(const f32x4*)(gn + 4 * lane + 256 * j); *(f32x4*)(row + 4 * lane + 256 * j) = v * rstd * g4; }
        }
    }
}
#undef IN
#undef SEAM

extern "C" void kernel_launch(void* const* d_in, const int* in_sizes, int n_in, void* d_out, int out_size, void* d_ws, size_t ws_size, hipStream_t stream) {
    static int grid = 0;
    if (grid == 0) {
        if (n_in != 25 || out_size != MMAIN * DM || ws_size < WS_END) { fprintf(stderr, "kernel_launch: unexpected shapes (n_in %d, out %d, ws %zu < %zu)\n", n_in, out_size, ws_size, (size_t)WS_END); grid = -1; return; }
        int dev = 0, cus = 0, per_cu = 0;
        hipGetDevice(&dev); hipDeviceGetAttribute(&cus, hipDeviceAttributeMultiprocessorCount, dev);
        if (hipFuncSetAttribute((const void*)fwd_kernel, hipFuncAttributeMaxDynamicSharedMemorySize, LDS_BYTES) != hipSuccess) { fprintf(stderr, "kernel_launch: hipFuncSetAttribute failed\n"); grid = -1; return; }
        if (hipOccupancyMaxActiveBlocksPerMultiprocessor(&per_cu, (const void*)fwd_kernel, NTHREADS, LDS_BYTES) != hipSuccess || per_cu < 1) { fprintf(stderr, "kernel_launch: occupancy query gave %d\n", per_cu); per_cu = 1; }
        (void)hipGetLastError();
        grid = cus * 1;
    }
    if (grid < 0) return;
    hipMemsetAsync((char*)d_ws + WS_CTL, 0, CTL_ZERO_BYTES, stream);
    Args a{};
    for (int i = 0; i < 25; ++i) a.in[i] = (const float*)d_in[i];
    a.out = (float*)d_out; a.ws = (unsigned char*)d_ws;
#if ONE_LAUNCH
    a.ph_lo = 0; a.ph_hi = NPHASES;
    void* kargs[] = {&a};
    hipError_t e = hipLaunchCooperativeKernel((const void*)fwd_kernel, dim3(grid), dim3(NTHREADS), kargs, LDS_BYTES, stream);
    if (e != hipSuccess) fprintf(stderr, "kernel_launch: cooperative launch failed: %s (grid %d)\n", hipGetErrorString(e), grid);
#else
    for (int ph = 0; ph < NPHASES; ++ph) { a.ph_lo = ph; a.ph_hi = ph + 1; hipLaunchKernelGGL(fwd_kernel, dim3(grid), dim3(NTHREADS), LDS_BYTES, stream, a); }
#endif
}
```

```cpp
#include <hip/hip_runtime.h>
#include <hip/hip_cooperative_groups.h>
#include <cstdio>
#include <cstdint>
namespace cg = cooperative_groups;
namespace pg8 {
#define PG8_LAS __attribute__((address_space(3)))
typedef unsigned short bf16_t;
typedef short bf16x8 __attribute__((ext_vector_type(8)));
typedef float f32x4 __attribute__((ext_vector_type(4)));
typedef unsigned u32x4 __attribute__((ext_vector_type(4)));
constexpr int BM = 256, BK = 64, HALF = 128, HTB = HALF * BK * 2  , STAGE_BYTES = 8 * HTB, NXCD = 8, WGM = 8;

__host__ __device__ __forceinline__ int lds_byte(int r, int c) { const int st = (r >> 4) * 2 + (c >> 5), rr = r & 15, cc = c & 31, ob = rr * 64 + cc * 2; return st * 1024 + (ob ^ (((ob >> 9) & 1) << 5)); }
__host__ __device__ __forceinline__ void stage_rc(int b, int& R, int& C) { const int st = b / 1024, sb = b % 1024, swz = sb ^ (((sb >> 9) & 1) << 5); R = (st >> 1) * 16 + swz / 64; C = (st & 1) * 32 + (swz % 64) / 2; }
__host__ __device__ __forceinline__ int perm32(int rho) { const int n = rho >> 4, i = rho & 15; return 8 * (i >> 2) + 4 * n + (i & 3); }

struct Unit { int pm, pn; };
struct Gemm { const bf16_t* A; const bf16_t* Bt; int M, N, K; };

struct StaticOrder {
    int nM, nN, nwg, G, c;
    __host__ __device__ void init(int M, int N, int G_, int c_) { nM = M / BM; nN = N / BM; nwg = nM * nN; G = G_; c = c_; }
    __host__ __device__ bool next(int i, Unit& u) const {
        const long L = (long)i * G + c; if (L >= nwg) return false;
        int wgid = (int)L; { const int q = nwg / NXCD, r = nwg % NXCD, xcd = wgid % NXCD, off = wgid / NXCD; wgid = (xcd < r ? xcd * (q + 1) : r * (q + 1) + (xcd - r) * q) + off; }
        const int nig = WGM * nN, gid = wgid / nig, fm = gid * WGM, gsz = (nM - fm) < WGM ? (nM - fm) : WGM;
        u.pm = fm + ((wgid % nig) % gsz); u.pn = (wgid % nig) / gsz; return true;
    }
    __device__ __forceinline__ void a_ready(const Unit&) const {}
    __device__ __forceinline__ void done(const Unit&) const {}
};

__device__ __forceinline__ unsigned cvt_pk_bf16(float lo, float hi) { unsigned r; asm volatile("v_cvt_pk_bf16_f32 %0, %1, %2" : "=v"(r) : "v"(lo), "v"(hi)); return r; }
__device__ __forceinline__ float bf_lo(unsigned w) { return __uint_as_float(w << 16); }
__device__ __forceinline__ float bf_hi(unsigned w) { return __uint_as_float(w & 0xffff0000u); }
__device__ __forceinline__ float sigmoid_f(float x) { return __builtin_amdgcn_rcpf(1.0f + __expf(-x)); }
__device__ __forceinline__ float silu_f(float x) { return x * sigmoid_f(x); }
constexpr int MMAIN_ROWS = 32768;
constexpr float NORM_EPS = 1e-6f;

struct EpiIn {
    static constexpr bool PERM = true, AFTER_DRAIN = false, MIDK = false;
    const float* rs; const float* lb;
    bf16_t* Q; bf16_t* Kb; float* LF; bf16_t* V; bf16_t* GS; bf16_t* U;
    static __device__ __forceinline__ void fgate(float z, float lbv, float& kk, float& lf) {
        z = fminf(fmaxf(z, -30.f), 30.f); const float e = __expf(-z), sg = __builtin_amdgcn_rcpf(1.0f + e);
        const float f = lbv + (1.0f - lbv) * sg; lf = __logf(fmaxf(f, 1e-6f)); kk = (1.0f - lbv) * (e * sg); }
    __device__ __forceinline__ void operator()(const f32x4 (&acc)[2][2][4][2], const Unit& u, int wr, int wc, int fr, int fq) const {
        const int seg = u.pn >> 2, colt = (u.pn & 3) * BM;
        const int row0 = u.pm * BM + wr * 64 + fr, col0 = colt + wc * 32 + 8 * fq;
        bf16_t* dst = seg == 0 ? Q : (seg == 1 ? Kb : (seg == 2 ? V : (seg == 3 ? GS : U)));
        float rstd8[2][4]; f32x4 lbv[2][2];
#pragma unroll
        for (int ai = 0; ai < 2; ++ai)
#pragma unroll
            for (int m = 0; m < 4; ++m) rstd8[ai][m] = rs[row0 + ai * HALF + m * 16];
#pragma unroll
        for (int bj = 0; bj < 2; ++bj) { lbv[bj][0] = seg == 1 ? *(const f32x4*)(lb + col0 + bj * HALF) : (f32x4){0.f, 0.f, 0.f, 0.f}; lbv[bj][1] = seg == 1 ? *(const f32x4*)(lb + col0 + bj * HALF + 4) : (f32x4){0.f, 0.f, 0.f, 0.f}; }
#pragma unroll
        for (int ai = 0; ai < 2; ++ai)
#pragma unroll
            for (int m = 0; m < 4; ++m) rstd8[ai][m] = rsqrtf(rstd8[ai][m] * (1.0f / 2048.0f) + NORM_EPS);
#pragma unroll
        for (int ai = 0; ai < 2; ++ai)
#pragma unroll
            for (int m = 0; m < 4; ++m) {
                const int row = row0 + ai * HALF + m * 16;
                const float rstd = rstd8[ai][m];
#pragma unroll
                for (int bj = 0; bj < 2; ++bj) {
                    const int c = col0 + bj * HALF; const size_t off = (size_t)row * 1024 + c;
                    f32x4 v0 = acc[ai][bj][m][0] * rstd, v1 = acc[ai][bj][m][1] * rstd;
                    if (seg == 1) {
                        const f32x4 l0 = lbv[bj][0], l1 = lbv[bj][1];
                        f32x4 k0, k1, f0, f1; float tk, tf;
#define FG(vv, ll, kk, ff, i) fgate(vv[i], ll[i], tk, tf); kk[i] = tk; ff[i] = tf;
                        FG(v0, l0, k0, f0, 0) FG(v0, l0, k0, f0, 1) FG(v0, l0, k0, f0, 2) FG(v0, l0, k0, f0, 3)
                        FG(v1, l1, k1, f1, 0) FG(v1, l1, k1, f1, 1) FG(v1, l1, k1, f1, 2) FG(v1, l1, k1, f1, 3)
#undef FG
                        *(f32x4*)(LF + off) = f0; *(f32x4*)(LF + off + 4) = f1;
                        v0 = k0; v1 = k1;
                    } else if (seg == 0 || seg == 3) {
                        v0 = (f32x4){silu_f(v0[0]), silu_f(v0[1]), silu_f(v0[2]), silu_f(v0[3])}; v1 = (f32x4){silu_f(v1[0]), silu_f(v1[1]), silu_f(v1[2]), silu_f(v1[3])};
                    }
                    u32x4 w; w.x = cvt_pk_bf16(v0[0], v0[1]); w.y = cvt_pk_bf16(v0[2], v0[3]); w.z = cvt_pk_bf16(v1[0], v1[1]); w.w = cvt_pk_bf16(v1[2], v1[3]);
                    *(u32x4*)(dst + off) = w;
                }
            }
    }
};

struct EpiGlu {
    static constexpr bool PERM = true, AFTER_DRAIN = false, MIDK = false;
    const bf16_t* Y; const float* bias; bf16_t* MIX; float* rs5;
    __device__ __forceinline__ void operator()(const f32x4 (&acc)[2][2][4][2], const Unit& u, int wr, int wc, int fr, int fq) const {
        const int row0 = u.pm * BM + wr * 64 + fr, col0 = u.pn * BM + wc * 32 + 8 * fq;
        f32x4 bsv[2][2];
#pragma unroll
        for (int bj = 0; bj < 2; ++bj) { bsv[bj][0] = *(const f32x4*)(bias + col0 + bj * HALF); bsv[bj][1] = *(const f32x4*)(bias + col0 + bj * HALF + 4); }
#pragma unroll
        for (int ai = 0; ai < 2; ++ai) {
            u32x4 ywv[4][2];
#pragma unroll
            for (int m = 0; m < 4; ++m)
#pragma unroll
                for (int bj = 0; bj < 2; ++bj) ywv[m][bj] = *(const u32x4*)(Y + (size_t)(row0 + ai * HALF + m * 16) * 1024 + col0 + bj * HALF);
#pragma unroll
            for (int m = 0; m < 4; ++m) {
                const int row = row0 + ai * HALF + m * 16; float ss = 0.f;
#pragma unroll
                for (int bj = 0; bj < 2; ++bj) {
                    const int c = col0 + bj * HALF;
                    const f32x4 b0 = bsv[bj][0], b1 = bsv[bj][1];
                    const u32x4 yw = ywv[m][bj];
                    float y[8] = {bf_lo(yw.x), bf_hi(yw.x), bf_lo(yw.y), bf_hi(yw.y), bf_lo(yw.z), bf_hi(yw.z), bf_lo(yw.w), bf_hi(yw.w)};
                    float o[8];
#pragma unroll
                    for (int j = 0; j < 8; ++j) { const float z = (j < 4 ? acc[ai][bj][m][0][j] + b0[j] : acc[ai][bj][m][1][j - 4] + b1[j - 4]); o[j] = y[j] * sigmoid_f(z); ss += o[j] * o[j]; }
                    u32x4 w; w.x = cvt_pk_bf16(o[0], o[1]); w.y = cvt_pk_bf16(o[2], o[3]); w.z = cvt_pk_bf16(o[4], o[5]); w.w = cvt_pk_bf16(o[6], o[7]);
                    *(u32x4*)(MIX + (size_t)row * 2048 + 1024 + c) = w;
                }
                ss += __shfl_xor(ss, 16); ss += __shfl_xor(ss, 32);
                if (fq == 0) atomicAdd(rs5 + row, ss);
            }
        }
    }
};

template <bool MIDS> struct EpiResT {
    static constexpr bool PERM = false, AFTER_DRAIN = false, MIDK = MIDS;
    float* hout; bf16_t* HB; float* rsn; const float* rs5;
    __device__ __forceinline__ void mid(f32x4 (&acc)[2][2][4][2], const Unit& u, int wr, int fr) const {
        const int row00 = u.pm * BM + wr * 64 + fr;
        float ri[2][4];
#pragma unroll
        for (int ai = 0; ai < 2; ++ai)
#pragma unroll
            for (int m = 0; m < 4; ++m) ri[ai][m] = rs5[row00 + ai * HALF + m * 16];
#pragma unroll
        for (int ai = 0; ai < 2; ++ai)
#pragma unroll
            for (int m = 0; m < 4; ++m) { const float rinv = sqrtf(ri[ai][m] * (1.0f / 1024.0f) + NORM_EPS);
#pragma unroll
                for (int bj = 0; bj < 2; ++bj)
#pragma unroll
                    for (int n = 0; n < 2; ++n) acc[ai][bj][m][n] = acc[ai][bj][m][n] * rinv; }
    }
    __device__ __forceinline__ void operator()(const f32x4 (&acc)[2][2][4][2], const Unit& u, int wr, int wc, int fr, int fq) const {
        typedef unsigned u32x2 __attribute__((ext_vector_type(2)));
        const int row00 = u.pm * BM + wr * 64 + fr, col0 = u.pn * BM + wc * 32 + 4 * fq;
        float rr[8];
#pragma unroll
        for (int gi = 0; gi < 8; ++gi) rr[gi] = MIDS ? rs5[row00 + (gi >> 2) * HALF + (gi & 3) * 16] : 0.f;
        u32x2 hv[2][2][2];
#pragma unroll
        for (int bj = 0; bj < 2; ++bj)
#pragma unroll
            for (int n = 0; n < 2; ++n) hv[0][bj][n] = *(const u32x2*)(HB + (size_t)row00 * 2048 + col0 + bj * HALF + n * 16);
#pragma unroll
        for (int gi = 0; gi < 8; ++gi) rr[gi] = MIDS ? rsqrtf(rr[gi] * (1.0f / 1024.0f) + NORM_EPS) : 1.0f;
#pragma unroll
        for (int gi = 0; gi < 8; ++gi) {
            const int ai = gi >> 2, m = gi & 3;
            const int row = row00 + ai * HALF + m * 16; float ss = 0.f;
            if (gi < 7) { const int rown = row00 + ((gi + 1) >> 2) * HALF + ((gi + 1) & 3) * 16;
#pragma unroll
                for (int bj = 0; bj < 2; ++bj)
#pragma unroll
                    for (int n = 0; n < 2; ++n) hv[(gi + 1) & 1][bj][n] = *(const u32x2*)(HB + (size_t)rown * 2048 + col0 + bj * HALF + n * 16); }
#pragma unroll
            for (int bj = 0; bj < 2; ++bj)
#pragma unroll
                for (int n = 0; n < 2; ++n) {
                    const int c = col0 + bj * HALF + n * 16; const u32x2 hw = hv[gi & 1][bj][n];
                    const f32x4 a = MIDS ? acc[ai][bj][m][n] * rr[gi] : acc[ai][bj][m][n];
                    const f32x4 o = (f32x4){bf_lo(hw.x), bf_hi(hw.x), bf_lo(hw.y), bf_hi(hw.y)} + a;
                    if (hout) *(f32x4*)(hout + (size_t)row * 2048 + c) = o;
                    ss += (o[0] * o[0] + o[1] * o[1]) + (o[2] * o[2] + o[3] * o[3]);
                    u32x2 w; w.x = cvt_pk_bf16(o[0], o[1]); w.y = cvt_pk_bf16(o[2], o[3]);
                    if (!hout) *(u32x2*)(HB + (size_t)row * 2048 + c) = w;
                }
            ss += __shfl_xor(ss, 16); ss += __shfl_xor(ss, 32);
            if (fq == 0) atomicAdd(rsn + row, ss);
        }
    }
};

template <int N> __device__ __forceinline__ float dpp_shr(float v) { return __builtin_bit_cast(float, __builtin_amdgcn_update_dpp(0, __builtin_bit_cast(int, v), 0x110 + N, 0xf, 0xf, true)); }
template <int N> __device__ __forceinline__ float dpp_shl(float v) { return __builtin_bit_cast(float, __builtin_amdgcn_update_dpp(0, __builtin_bit_cast(int, v), 0x100 + N, 0xf, 0xf, true)); }
struct EpiGU {
    static constexpr bool PERM = true, AFTER_DRAIN = false, MIDK = false;
    const float* rs; bf16_t* Hd; const float* cw; const float* cb; float* sideA; float* sideU; float* metaA;
    __device__ __forceinline__ void operator()(const f32x4 (&acc)[2][2][4][2], const Unit& u, int wr, int wc, int fr, int fq) const {
        const int lane = threadIdx.x & 63;
        const int f0 = u.pn * HALF + wc * 32 + 8 * fq;
        float rstd8[2][4]; f32x4 cwv[2][4];
#pragma unroll
        for (int ai = 0; ai < 2; ++ai)
#pragma unroll
            for (int m = 0; m < 4; ++m) rstd8[ai][m] = rs[u.pm * BM + ai * HALF + wr * 64 + fr + m * 16];
#pragma unroll
        for (int n = 0; n < 2; ++n) { const int f = f0 + 4 * n; cwv[n][0] = *(const f32x4*)(cw + f); cwv[n][1] = *(const f32x4*)(cw + 5632 + f); cwv[n][2] = *(const f32x4*)(cw + 2 * 5632 + f); cwv[n][3] = *(const f32x4*)(cb + f); }
#pragma unroll
        for (int ai = 0; ai < 2; ++ai) {
            const int seg = u.pm * 4 + ai * 2 + wr, rowb = u.pm * BM + ai * HALF + wr * 64 + fr;
            float rstd[4];
#pragma unroll
            for (int m = 0; m < 4; ++m) rstd[m] = rsqrtf(rstd8[ai][m] * (1.0f / 2048.0f) + NORM_EPS);
            unsigned pk[4][2][2];
#pragma unroll
            for (int n = 0; n < 2; ++n) {
                const int f = f0 + 4 * n;
                const f32x4 w0 = cwv[n][0], w1 = cwv[n][1], w2 = cwv[n][2], bb = cwv[n][3];
                f32x4 g[4], up[4];
#pragma unroll
                for (int m = 0; m < 4; ++m) { g[m] = acc[ai][0][m][n] * rstd[m]; up[m] = acc[ai][1][m][n] * rstd[m]; }
                if (fr < 2) { *(f32x4*)(sideA + (size_t)(seg * 4 + fr) * 5632 + f) = g[0]; *(f32x4*)(sideU + (size_t)(seg * 2 + fr) * 5632 + f) = up[0]; }
                if (fr >= 14) { *(f32x4*)(sideA + (size_t)(seg * 4 + 2 + fr - 14) * 5632 + f) = g[3];
                    if (u.pm * BM >= MMAIN_ROWS && ai == 0 && wr == 0) *(f32x4*)(metaA + (size_t)(fr - 14) * 5632 + f) = g[0]; }
#pragma unroll
                for (int m = 0; m < 4; ++m) {
                    float hv[4];
#pragma unroll
                    for (int j = 0; j < 4; ++j) {
                        float p1 = dpp_shr<1>(g[m][j]), p2 = dpp_shr<2>(g[m][j]);
                        if (m > 0) { p1 += dpp_shl<15>(g[m > 0 ? m - 1 : 0][j]); p2 += dpp_shl<14>(g[m > 0 ? m - 1 : 0][j]); }
                        const float cv = bb[j] + w0[j] * p2 + w1[j] * p1 + w2[j] * g[m][j];
                        hv[j] = silu_f(cv) * up[m][j];
                    }
                    pk[m][n][0] = cvt_pk_bf16(hv[0], hv[1]); pk[m][n][1] = cvt_pk_bf16(hv[2], hv[3]);
                }
            }
#pragma unroll
            for (int m = 0; m < 4; ++m) { u32x4 w; w.x = pk[m][0][0]; w.y = pk[m][0][1]; w.z = pk[m][1][0]; w.w = pk[m][1][1];
                *(u32x4*)(Hd + (size_t)(rowb + m * 16) * 5632 + f0) = w; }
        }
    }
};

template <class Epi, class Sched, bool ALIGN_EPI = false, bool SP2 = false>
__device__ __forceinline__ void gemm_phase(PG8_LAS unsigned char* lds, const Gemm g, const Sched& S, const Epi& E) {
    int tid_ = threadIdx.x; asm volatile("" : "+v"(tid_));
    const int tid = tid_, wid = __builtin_amdgcn_readfirstlane(tid >> 6), lane = tid & 63, wr = wid >> 2, wc = wid & 3, fr = lane & 15, fq = lane >> 4;
    const int K = g.K, nt = K / BK;
    unsigned voffA[2], voffB[2];
#pragma unroll
    for (int i = 0; i < 2; ++i) { int R, C; stage_rc(tid * 16 + i * 8192, R, C); const int Rb = Epi::PERM ? ((R & ~31) + perm32(R & 31)) : R;
        voffA[i] = (unsigned)(R * K + C) * 2u; voffB[i] = (unsigned)(Rb * K + C) * 2u; }
    const size_t kstep = (size_t)(BK * 2);
    const size_t hstep = (size_t)HALF * K * 2;
    const size_t tstep = 2 * hstep;
    const unsigned ldsw = (unsigned)wid * 1024u;
    const int aoff = lds_byte(wr * 64 + fr, fq * 8), boff = lds_byte(wc * 32 + fr, fq * 8);
#define PG8_SA(b, h) (((b) * 2 + (h)) * HTB)
#define PG8_SB(b, h) ((4 + (b) * 2 + (h)) * HTB)
#define PG8_STAGE(bufoff, gbase, voff) do { _Pragma("unroll") for (int _i = 0; _i < 2; ++_i) \
        __builtin_amdgcn_global_load_lds((const unsigned*)((const char*)(gbase) + (voff)[_i]), (PG8_LAS unsigned*)(lds + (bufoff) + ldsw + _i * 8192), 16, 0, 0); } while (0)
#define PG8_LDA(dst, b, h) do { _Pragma("unroll") for (int m = 0; m < 4; ++m) _Pragma("unroll") for (int k = 0; k < 2; ++k) dst[m][k] = *(const PG8_LAS bf16x8*)(lds + PG8_SA(b, h) + aoff + m * 2048 + k * 1024); } while (0)
#define PG8_LDB(dst, b, h) do { _Pragma("unroll") for (int n = 0; n < 2; ++n) _Pragma("unroll") for (int k = 0; k < 2; ++k) dst[n][k] = *(const PG8_LAS bf16x8*)(lds + PG8_SB(b, h) + boff + n * 2048 + k * 1024); } while (0)
#define PG8_MMA(ai, bj, At, Bt) do { __builtin_amdgcn_s_setprio(1); _Pragma("unroll") for (int m = 0; m < 4; ++m) _Pragma("unroll") for (int n = 0; n < 2; ++n) _Pragma("unroll") for (int k = 0; k < 2; ++k) \
        acc[ai][bj][m][n] = __builtin_amdgcn_mfma_f32_16x16x32_bf16(Bt[n][k], At[m][k], acc[ai][bj][m][n], 0, 0, 0); __builtin_amdgcn_s_setprio(0); } while (0)
#define PG8_WAIT_V(n) asm volatile("s_waitcnt vmcnt(" #n ")" ::: "memory")
#define PG8_WAIT_L(n) asm volatile("s_waitcnt lgkmcnt(" #n ")" ::: "memory")
#define PG8_BAR __builtin_amdgcn_s_barrier()
#define PG8_SCHED __builtin_amdgcn_sched_barrier(0)
    Unit cur, nxt; int ui = 0;
    if (!S.next(0, cur)) return;
    f32x4 acc[2][2][4][2];
#pragma unroll
    for (int a = 0; a < 2; ++a)
#pragma unroll
        for (int b = 0; b < 2; ++b)
#pragma unroll
            for (int m = 0; m < 4; ++m)
#pragma unroll
                for (int n = 0; n < 2; ++n) acc[a][b][m][n] = (f32x4){0.f, 0.f, 0.f, 0.f};
    bf16x8 At[4][2], B0[2][2], B1[2][2];
    const char* cA = (const char*)g.A + (size_t)cur.pm * tstep; const char* cB = (const char*)g.Bt + (size_t)cur.pn * tstep;
    S.a_ready(cur);
    if constexpr (SP2) {
        PG8_STAGE(PG8_SB(0, 0), cB, voffB); PG8_STAGE(PG8_SB(0, 1), cB + hstep, voffB); PG8_STAGE(PG8_SA(0, 0), cA, voffA); PG8_STAGE(PG8_SA(0, 1), cA + hstep, voffA);
        if (wr == 1) PG8_BAR;
        PG8_WAIT_V(2); PG8_BAR;
        PG8_STAGE(PG8_SB(1, 0), cB + kstep, voffB); PG8_STAGE(PG8_SA(1, 0), cA + kstep, voffA); PG8_STAGE(PG8_SB(1, 1), cB + hstep + kstep, voffB);
        PG8_WAIT_V(6); PG8_BAR;
    } else {
        PG8_STAGE(PG8_SB(0, 0), cB, voffB); PG8_STAGE(PG8_SA(0, 0), cA, voffA); PG8_STAGE(PG8_SB(0, 1), cB + hstep, voffB); PG8_STAGE(PG8_SA(0, 1), cA + hstep, voffA);
        if (wr == 1) PG8_BAR;
        PG8_WAIT_V(4); PG8_BAR;
        PG8_STAGE(PG8_SB(1, 0), cB + kstep, voffB); PG8_STAGE(PG8_SA(1, 0), cA + kstep, voffA); PG8_STAGE(PG8_SB(1, 1), cB + hstep + kstep, voffB);
        PG8_WAIT_V(6); PG8_BAR;
    }
    for (;;) {
        const bool has_next = S.next(ui + 1, nxt);
        const char* nA = has_next ? (const char*)g.A + (size_t)nxt.pm * tstep : cA; const char* nB = has_next ? (const char*)g.Bt + (size_t)nxt.pn * tstep : cB;
        for (int t = 0; t < nt; t += 2) {
            const bool last = (t == nt - 2);
            const char* a1 = cA + (size_t)(t + 1) * kstep;
            const char* a2 = last ? nA : cA + (size_t)(t + 2) * kstep; const char* b2 = last ? nB : cB + (size_t)(t + 2) * kstep;
            const char* a3 = a2 + kstep; const char* b3 = b2 + kstep;
            if constexpr (Epi::MIDK) { if (t == (nt >> 1)) E.mid(acc, cur, wr, fr); }
            if (last && has_next) S.a_ready(nxt);
            if constexpr (SP2) {
            PG8_LDB(B0, 0, 0); PG8_LDB(B1, 0, 1); PG8_SCHED; PG8_LDA(At, 0, 0); PG8_STAGE(PG8_SA(1, 1), a1 + hstep, voffA);
            PG8_WAIT_V(8); PG8_WAIT_L(0); PG8_BAR; PG8_MMA(0, 0, At, B0); PG8_MMA(0, 1, At, B1); PG8_BAR; PG8_SCHED;
            PG8_LDA(At, 0, 1); PG8_STAGE(PG8_SB(0, 0), b2, voffB); PG8_STAGE(PG8_SB(0, 1), b2 + hstep, voffB); PG8_STAGE(PG8_SA(0, 0), a2, voffA);
            PG8_WAIT_V(8); PG8_WAIT_L(0); PG8_BAR; PG8_MMA(1, 0, At, B0); PG8_MMA(1, 1, At, B1); PG8_BAR; PG8_SCHED;
            PG8_LDB(B0, 1, 0); PG8_LDB(B1, 1, 1); PG8_SCHED; PG8_LDA(At, 1, 0); PG8_STAGE(PG8_SA(0, 1), a2 + hstep, voffA);
            PG8_WAIT_V(8); PG8_WAIT_L(0); PG8_BAR; PG8_MMA(0, 0, At, B0); PG8_MMA(0, 1, At, B1); PG8_BAR; PG8_SCHED;
            PG8_LDA(At, 1, 1); PG8_STAGE(PG8_SB(1, 0), b3, voffB); PG8_STAGE(PG8_SB(1, 1), b3 + hstep, voffB); PG8_STAGE(PG8_SA(1, 0), a3, voffA);
            PG8_WAIT_V(8); PG8_WAIT_L(0); PG8_BAR; PG8_MMA(1, 0, At, B0); PG8_MMA(1, 1, At, B1); PG8_BAR; PG8_SCHED;
            } else {
            PG8_LDB(B0, 0, 0); PG8_SCHED; PG8_LDA(At, 0, 0); PG8_STAGE(PG8_SA(1, 1), a1 + hstep, voffA);
            PG8_WAIT_L(8); PG8_BAR; PG8_WAIT_L(0); PG8_MMA(0, 0, At, B0); PG8_BAR; PG8_SCHED;
            PG8_LDB(B1, 0, 1); PG8_STAGE(PG8_SB(0, 0), b2, voffB);
            PG8_BAR; PG8_WAIT_L(0); PG8_MMA(0, 1, At, B1); PG8_BAR;
            PG8_LDA(At, 0, 1); PG8_STAGE(PG8_SA(0, 0), a2, voffA);
            PG8_BAR; PG8_WAIT_L(0); PG8_MMA(1, 0, At, B0); PG8_BAR; PG8_SCHED;
            PG8_STAGE(PG8_SB(0, 1), b2 + hstep, voffB);
            PG8_WAIT_V(6); PG8_BAR; PG8_MMA(1, 1, At, B1); PG8_BAR;
            PG8_LDB(B0, 1, 0); PG8_SCHED; PG8_LDA(At, 1, 0); PG8_STAGE(PG8_SA(0, 1), a2 + hstep, voffA);
            PG8_WAIT_L(8); PG8_BAR; PG8_WAIT_L(0); PG8_MMA(0, 0, At, B0); PG8_BAR; PG8_SCHED;
            PG8_LDB(B1, 1, 1); PG8_STAGE(PG8_SB(1, 0), b3, voffB);
            PG8_BAR; PG8_WAIT_L(0); PG8_MMA(0, 1, At, B1); PG8_BAR;
            PG8_LDA(At, 1, 1); PG8_STAGE(PG8_SA(1, 0), a3, voffA);
            PG8_BAR; PG8_WAIT_L(0); PG8_MMA(1, 0, At, B0); PG8_BAR; PG8_SCHED;
            PG8_STAGE(PG8_SB(1, 1), b3 + hstep, voffB);
            PG8_WAIT_V(6); PG8_BAR; PG8_MMA(1, 1, At, B1); PG8_BAR;
            }
        }
        if constexpr (ALIGN_EPI) { if (wr == 0) PG8_BAR; }
        if constexpr (!Epi::AFTER_DRAIN) { E(acc, cur, wr, wc, fr, fq); S.done(cur); }
        if (!has_next) break;
#pragma unroll
        for (int a = 0; a < 2; ++a)
#pragma unroll
            for (int b = 0; b < 2; ++b)
#pragma unroll
                for (int m = 0; m < 4; ++m)
#pragma unroll
                    for (int n = 0; n < 2; ++n) acc[a][b][m][n] = (f32x4){0.f, 0.f, 0.f, 0.f};
        cur = nxt; cA = nA; cB = nB; ++ui;
        if constexpr (ALIGN_EPI) { if (wr == 1) PG8_BAR; }
    }
    PG8_WAIT_V(0);
    if constexpr (!ALIGN_EPI) { if (wr == 0) PG8_BAR; }
    PG8_BAR;
    if constexpr (Epi::AFTER_DRAIN) { E.fused(acc, cur, wr, wc, fr, fq, lds, wid, lane); S.done(cur); }
#undef PG8_SA
#undef PG8_SB
#undef PG8_STAGE
#undef PG8_LDA
#undef PG8_LDB
#undef PG8_MMA
#undef PG8_WAIT_V
#undef PG8_WAIT_L
#undef PG8_BAR
#undef PG8_SCHED
}
}
#define LAS __attribute__((address_space(3)))
typedef unsigned short bf16;
typedef float f32x4 __attribute__((ext_vector_type(4)));
typedef unsigned v4u __attribute__((ext_vector_type(4)));
typedef unsigned v2u __attribute__((ext_vector_type(2)));
typedef short bf16x8 __attribute__((ext_vector_type(8)));
constexpr int DM = 2048, SEQ = 2048, BATCH = 16, NMETA = 16, DEPTH = 2;
constexpr int DHG = 1024, DS5 = 1024, DIN = 5120, DFF = 5632;
constexpr int MMAIN = BATCH * SEQ;
constexpr int META0 = MMAIN;
constexpr int MPAD = MMAIN + 256;
constexpr int NSEGS = MPAD / 64;
constexpr float EPS = 1e-6f;
constexpr int NWAVES = 8, NTHREADS = 512;
constexpr int LDS_BYTES = 147456;

constexpr size_t MiB = 1u << 20;
constexpr size_t WS_CTL = 0, CTL_ZERO_BYTES = 2 * MiB;
constexpr size_t WS_BAR_OFF = 1 * MiB;
constexpr size_t RS_STRIDE = MPAD;
constexpr size_t WS_S5A = 2 * MiB;
constexpr size_t WS_S5B = 2 * MiB + 128 * 1024;
constexpr size_t WS_LB = 3 * MiB + 512 * 1024;
constexpr size_t WS_HMETA = 4 * MiB;
constexpr size_t WS_METAA = 6 * MiB;
constexpr size_t WS_W = 8 * MiB, W_LAYER = 96 * MiB;
constexpr size_t W_IN = 0, W_GLU = 20 * MiB, W_OUT = 22 * MiB, W_GU = 30 * MiB, W_DN = 74 * MiB;
constexpr size_t WS_HB = 200 * MiB;
constexpr size_t WS_MIX = 329 * MiB;
constexpr size_t WS_SIDEA = WS_MIX, WS_SIDEU = WS_MIX + 48 * MiB;
constexpr size_t WS_R = 458 * MiB;
constexpr size_t PB = (size_t)MPAD * 1024 * 2;
constexpr size_t WS_Q = WS_R, WS_K = WS_R + PB, WS_V = WS_R + 2 * PB, WS_GS = WS_R + 3 * PB, WS_U = WS_R + 4 * PB, WS_LF = WS_R + 5 * PB;
constexpr size_t WS_HID = WS_R;
constexpr size_t WS_Y = WS_R + 7 * PB;
constexpr size_t WS_END = WS_R + 8 * PB;
static_assert((size_t)NSEGS * 4 * 5632 * 4 <= 48 * MiB && WS_SIDEU + (size_t)NSEGS * 2 * 5632 * 4 <= WS_R, "side buffers inside the mix region");
static_assert((size_t)MPAD * 5632 * 2 <= 7 * PB && WS_END <= 1024 * MiB, "workspace map");

__device__ __forceinline__ unsigned f2bf(float f) { unsigned u = __builtin_bit_cast(unsigned, f); return (u + 0x7fffu + ((u >> 16) & 1u)) >> 16; }
__device__ __forceinline__ unsigned pk2(float lo, float hi) { return f2bf(lo) | (f2bf(hi) << 16); }
__device__ __forceinline__ float bflo(unsigned w) { return __uint_as_float(w << 16); }
__device__ __forceinline__ float bfhi(unsigned w) { return __uint_as_float(w & 0xffff0000u); }
__device__ __forceinline__ float wave_sum(float v) {
#pragma unroll
    for (int o = 1; o < 64; o <<= 1) v += __shfl_xor(v, o);
    return v;
}
#define LDS_WAIT() asm volatile("s_waitcnt lgkmcnt(0)" ::: "memory")
#define LDS_BAR() asm volatile("s_waitcnt lgkmcnt(0)\n\ts_barrier" ::: "memory")

struct Args { const float* in[25]; float* out; unsigned char* ws; int ph_lo, ph_hi; };

__device__ __forceinline__ void transpose_item(const float* W, int K, int N, bf16* WT, int drow0, const float* kscale, LAS float* scr, int k0, int n0, int lane) {
    const int lr = lane >> 4, lc = (lane & 15) * 4;
    f32x4 v[16];
#pragma unroll
    for (int i = 0; i < 16; ++i) v[i] = *(const f32x4*)(W + (size_t)(k0 + 4 * i + lr) * N + n0 + lc);
#pragma unroll
    for (int i = 0; i < 16; ++i) { const int kk = 4 * i + lr; const float sc = kscale ? kscale[k0 + kk] : 1.0f; LAS float* p = scr + kk * 65 + lc;
        p[0] = v[i][0] * sc; p[1] = v[i][1] * sc; p[2] = v[i][2] * sc; p[3] = v[i][3] * sc; }
    LDS_WAIT(); asm volatile("" ::: "memory");
    const int c = lane & 7;
#pragma unroll
    for (int j = 0; j < 8; ++j) { const int n = (lane >> 3) + 8 * j; const LAS float* s = scr + (8 * c) * 65 + n;
        v4u o; o.x = pk2(s[0 * 65], s[1 * 65]); o.y = pk2(s[2 * 65], s[3 * 65]); o.z = pk2(s[4 * 65], s[5 * 65]); o.w = pk2(s[6 * 65], s[7 * 65]);
        *(v4u*)(WT + (size_t)(drow0 + n) * K + k0 + 8 * c) = o; }
    LDS_WAIT(); asm volatile("" ::: "memory");
}

__device__ __forceinline__ void p0_prologue(const Args& a, LAS unsigned char* lds) {
    int tid = threadIdx.x; asm volatile("" : "+v"(tid));
    const int lane = tid & 63, wave = tid >> 6;
    const int gw = blockIdx.x * NWAVES + wave, NGW = gridDim.x * NWAVES;
    unsigned char* ws = a.ws;
    LAS float* scr = (LAS float*)(lds + wave * 16640);
    constexpr int I_IN = 32 * 80, I_GLU = 16 * 16, I_OUT = 32 * 32, I_G = 32 * 88, I_DN = 88 * 32, PER_L = I_IN + I_GLU + I_OUT + 2 * I_G + I_DN;
    for (int it = gw; it < DEPTH * PER_L; it += NGW) {
        const int l = it / PER_L; int r = it % PER_L;
        unsigned char* wl = ws + WS_W + (size_t)l * W_LAYER;
        if (r < I_IN) { transpose_item(a.in[4] + (size_t)l * DM * DIN, DM, DIN, (bf16*)(wl + W_IN), 64 * (r % 80), a.in[3] + l * DM, scr, 64 * (r / 80), 64 * (r % 80), lane); continue; } r -= I_IN;
        if (r < I_GLU) { transpose_item(a.in[14] + (size_t)l * DS5 * DS5, DS5, DS5, (bf16*)(wl + W_GLU), 64 * (r % 16), nullptr, scr, 64 * (r / 16), 64 * (r % 16), lane); continue; } r -= I_GLU;
        if (r < I_OUT) { const int k0 = 64 * (r / 32);
            transpose_item(a.in[17] + (size_t)l * DM * DM, DM, DM, (bf16*)(wl + W_OUT), 64 * (r % 32), k0 >= DHG ? a.in[16] + l * DS5 - DHG : nullptr, scr, k0, 64 * (r % 32), lane); continue; } r -= I_OUT;
        if (r < 2 * I_G) { const int up = r >= I_G; if (up) r -= I_G; const int n0 = 64 * (r % 88), drow0 = 256 * (n0 / 128) + (n0 % 128) + (up ? 128 : 0);
            transpose_item(a.in[up ? 20 : 19] + (size_t)l * DM * DFF, DM, DFF, (bf16*)(wl + W_GU), drow0, a.in[18] + l * DM, scr, 64 * (r / 88), n0, lane); continue; } r -= 2 * I_G;
        transpose_item(a.in[23] + (size_t)l * DFF * DM, DFF, DM, (bf16*)(wl + W_DN), 64 * (r % 32), nullptr, scr, 64 * (r / 32), 64 * (r % 32), lane);
    }
    float* rs0 = (float*)(ws + WS_CTL); bf16* HB = (bf16*)(ws + WS_HB);
    for (int m = gw; m < MPAD; m += NGW) {
        const float* src = m < MMAIN ? a.in[0] + (size_t)m * DM : (m < MMAIN + NMETA ? a.in[1] + (size_t)(m - MMAIN) * DM : nullptr);
        f32x4 v[8]; float ss = 0.f;
#pragma unroll
        for (int j = 0; j < 8; ++j) { v[j] = src ? *(const f32x4*)(src + 4 * lane + 256 * j) : (f32x4){0.f, 0.f, 0.f, 0.f}; ss += (v[j][0] * v[j][0] + v[j][1] * v[j][1]) + (v[j][2] * v[j][2] + v[j][3] * v[j][3]); }
        ss = wave_sum(ss);
#pragma unroll
        for (int j = 0; j < 8; ++j) { v2u w; w.x = pk2(v[j][0], v[j][1]); w.y = pk2(v[j][2], v[j][3]); *(v2u*)(HB + (size_t)m * DM + 4 * lane + 256 * j) = w;
}
        if (lane == 0) rs0[m] = ss;
    }
    const int gt = blockIdx.x * NTHREADS + tid, NGT = gridDim.x * NTHREADS;
    float* S5A = (float*)(ws + WS_S5A); float* S5B = (float*)(ws + WS_S5B); float* LB = (float*)(ws + WS_LB);
    for (int i = gt; i < DEPTH * 64 * 64; i += NGT) {
        const int lg = i >> 6;
        const float are = fminf(a.in[6][i], -1e-4f), aim = a.in[7][i], dt = expf(a.in[8][lg]);
        const float mag = expf(are * dt), abr = mag * cosf(aim * dt), abi = mag * sinf(aim * dt);
        const float den = are * are + aim * aim, xre = abr - 1.0f, xim = abi;
        const float zre = (xre * are + xim * aim) / den, zim = (xim * are - xre * aim) / den;
        S5A[2 * i] = abr; S5A[2 * i + 1] = abi;
        for (int h = 0; h < 16; ++h) { const float br = a.in[9][(size_t)i * 16 + h], bi = a.in[10][(size_t)i * 16 + h];
            S5B[((size_t)i * 16 + h) * 2] = zre * br - zim * bi; S5B[((size_t)i * 16 + h) * 2 + 1] = zre * bi + zim * br; }
    }
    for (int i = gt; i < DHG; i += NGT) {
        const float x0 = a.in[2][i], x1 = a.in[2][DHG + i], mx = fmaxf(x0, x1), e0 = expf(x0 - mx), e1 = expf(x1 - mx), s0 = e0 / (e0 + e1), s1 = e1 / (e0 + e1);
        LB[i] = s0 - s0; LB[DHG + i] = (s0 + s1) - s0;
    }
}

typedef __bf16 bf16x2_t __attribute__((ext_vector_type(2)));
typedef float f32x2_t __attribute__((ext_vector_type(2)));
__device__ __forceinline__ unsigned cvtpk(float lo, float hi) { f32x2_t v = {lo, hi}; bf16x2_t b = __builtin_convertvector(v, bf16x2_t); return __builtin_bit_cast(unsigned, b); }
__device__ __forceinline__ bf16x8 as_frag(unsigned a, unsigned b, unsigned c, unsigned d) { v4u t; t.x = a; t.y = b; t.z = c; t.w = d; return __builtin_bit_cast(bf16x8, t); }
constexpr int HG_RAW = 20480, HG_TILE0 = 2 * HG_RAW, HG_TILE = 21760, HG_SS0 = HG_TILE0 + 2 * HG_TILE;
__device__ __forceinline__ void hg_estage(LAS unsigned char* raw, LAS unsigned char* tile, int d, int tq) {
    const LAS float* RAWG = (const LAS float*)raw; const LAS bf16* RAWQ = (const LAS bf16*)(raw + 8192); const LAS bf16* RAWK = (const LAS bf16*)(raw + 12288); const LAS bf16* RAWV = (const LAS bf16*)(raw + 16384);
    LAS bf16* QA = (LAS bf16*)tile; LAS bf16* QM = (LAS bf16*)(tile + 4352); LAS bf16* KM = (LAS bf16*)(tile + 8704); LAS bf16* KBT = (LAS bf16*)(tile + 13056); LAS bf16* VT = (LAS bf16*)(tile + 17152); LAS float* DEC = (LAS float*)(tile + 21248);
    float g[16];
#pragma unroll
    for (int t = 0; t < 16; ++t) g[t] = RAWG[t * 128 + d];
    const float s0 = (g[0] + g[1]) + (g[2] + g[3]), s1 = (g[4] + g[5]) + (g[6] + g[7]), s2 = (g[8] + g[9]) + (g[10] + g[11]), s3 = (g[12] + g[13]) + (g[14] + g[15]);
    const float b7 = s0 + s1, bl = b7 + (s2 + s3);
    float run = (tq > 0 ? s0 : 0.f) + (tq > 1 ? s1 : 0.f) + (tq > 2 ? s2 : 0.f);
    float kbv[4]; unsigned vv[4];
#pragma unroll
    for (int j = 0; j < 4; ++j) {
        const int t = 4 * tq + j;
        run += RAWG[t * 128 + d];
        const float q = __uint_as_float((unsigned)RAWQ[t * 128 + d] << 16), k = __uint_as_float((unsigned)RAWK[t * 128 + d] << 16);
        vv[j] = RAWV[t * 128 + d];
        const float qa = q * __expf(run), qm = q * __expf(fminf(run - b7, 80.f)), km = k * __expf(fminf(b7 - run, 80.f));
        kbv[j] = k * __expf(bl - run);
        QA[t * 136 + d] = (bf16)cvtpk(qa, 0.f); QM[t * 136 + d] = (bf16)cvtpk(qm, 0.f); KM[t * 136 + d] = (bf16)cvtpk(km, 0.f);
    }
    v2u kw; kw.x = cvtpk(kbv[0], kbv[1]); kw.y = cvtpk(kbv[2], kbv[3]); *(LAS v2u*)(KBT + d * 16 + 4 * tq) = kw;
    v2u vw; vw.x = vv[0] | (vv[1] << 16); vw.y = vv[2] | (vv[3] << 16); *(LAS v2u*)(VT + d * 16 + 4 * tq) = vw;
    if (tq == 0) DEC[d] = __expf(bl);
}
__device__ __forceinline__ f32x4 hg_mstage(const LAS unsigned char* tile, LAS float* SS, f32x4 (&S)[8], int w, int fr, int fq) {
    const LAS bf16* QA = (const LAS bf16*)tile; const LAS bf16* QM = (const LAS bf16*)(tile + 4352); const LAS bf16* KM = (const LAS bf16*)(tile + 8704); const LAS bf16* KBT = (const LAS bf16*)(tile + 13056); const LAS bf16* VT = (const LAS bf16*)(tile + 17152); const LAS float* DEC = (const LAS float*)(tile + 21248);
    const int e0 = 16 * w;
    f32x4 accP = {0.f, 0.f, 0.f, 0.f}, accO = {0.f, 0.f, 0.f, 0.f};
#pragma unroll
    for (int ks = 0; ks < 4; ++ks) { const bf16x8 a = *(const LAS bf16x8*)(KM + fr * 136 + 32 * ks + 8 * fq), bq = *(const LAS bf16x8*)(QM + fr * 136 + 32 * ks + 8 * fq);
        accP = __builtin_amdgcn_mfma_f32_16x16x32_bf16(a, bq, accP, 0, 0, 0); }
    float p[4];
#pragma unroll
    for (int r = 0; r < 4; ++r) p[r] = (4 * fq + r <= fr) ? accP[r] : 0.f;
    const bf16x8 pa = as_frag(cvtpk(p[0], p[1]), cvtpk(p[2], p[3]), 0u, 0u);
    const v2u vt2 = *(const LAS v2u*)(VT + (e0 + fr) * 16 + 4 * fq); const bf16x8 vb = as_frag(vt2.x, vt2.y, 0u, 0u);
#pragma unroll
    for (int ks = 0; ks < 4; ++ks) {
        const bf16x8 sb = as_frag(cvtpk(S[2 * ks][0], S[2 * ks][1]), cvtpk(S[2 * ks][2], S[2 * ks][3]), cvtpk(S[2 * ks + 1][0], S[2 * ks + 1][1]), cvtpk(S[2 * ks + 1][2], S[2 * ks + 1][3]));
        const v2u alo = *(const LAS v2u*)(QA + fr * 136 + 32 * ks + 4 * fq), ahi = *(const LAS v2u*)(QA + fr * 136 + 32 * ks + 16 + 4 * fq);
        accO = __builtin_amdgcn_mfma_f32_16x16x32_bf16(as_frag(alo.x, alo.y, ahi.x, ahi.y), sb, accO, 0, 0, 0); }
    accO = __builtin_amdgcn_mfma_f32_16x16x32_bf16(pa, vb, accO, 0, 0, 0);
#pragma unroll
    for (int T = 0; T < 8; ++T) { const f32x4 dc = *(const LAS f32x4*)(DEC + 16 * T + 4 * fq); S[T] = S[T] * dc;
        const v2u kk = *(const LAS v2u*)(KBT + (16 * T + fr) * 16 + 4 * fq);
        S[T] = __builtin_amdgcn_mfma_f32_16x16x32_bf16(as_frag(kk.x, kk.y, 0u, 0u), vb, S[T], 0, 0, 0); }
    f32x4 sq = accO * accO;
#pragma unroll
    for (int x = 1; x < 16; x <<= 1) { sq[0] += __shfl_xor(sq[0], x); sq[1] += __shfl_xor(sq[1], x); sq[2] += __shfl_xor(sq[2], x); sq[3] += __shfl_xor(sq[3], x); }
    if (fr == 0) *(LAS f32x4*)(SS + w * 16 + 4 * fq) = sq;
    return accO;
}
__device__ __forceinline__ void hgrn2_item(LAS unsigned char* lds, const int tid, int b, int h, const bf16* Q, const bf16* Kb, const float* LF, const bf16* V, const bf16* GS, bf16* MIX, const float* gain) {
    const int lane = tid & 63, w = __builtin_amdgcn_readfirstlane(tid >> 6), fr = lane & 15, fq = lane >> 4, e0 = 16 * w;
    const int d = tid & 127, tq = __builtin_amdgcn_readfirstlane(tid >> 7);
    const int gt = tid >> 5, gd = (tid & 31) * 4, bt = (tid & 255) >> 4, bd = (tid & 15) * 8;
    const bool lowhalf = tid < 256;
    const bf16* src0 = lowhalf ? Q : Kb; const int raw0off = lowhalf ? 8192 : 12288;
    f32x4 rg; v4u r0, r1 = {0u, 0u, 0u, 0u};
    f32x4 S[8];
#pragma unroll
    for (int T = 0; T < 8; ++T) S[T] = (f32x4){0.f, 0.f, 0.f, 0.f};
    const float gn = gain[h * 128 + e0 + fr];
#define HG_ROW0(c) ((c) == 0 ? META0 : b * SEQ + 16 * ((c) - 1))
#define HG_L(c) do { const int rn_ = HG_ROW0(c); const size_t go_ = (size_t)(rn_ + gt) * 1024 + h * 128 + gd, bo_ = (size_t)(rn_ + bt) * 1024 + h * 128 + bd; \
        rg = *(const f32x4*)(LF + go_); r0 = *(const v4u*)(src0 + bo_); if (lowhalf) r1 = *(const v4u*)(V + bo_); } while (0)
#define HG_W(c) do { LAS unsigned char* raw_ = lds + ((c) & 1) * HG_RAW; *(LAS f32x4*)(raw_ + (gt * 128 + gd) * 4) = rg; *(LAS v4u*)(raw_ + raw0off + (bt * 128 + bd) * 2) = r0; \
        if (lowhalf) *(LAS v4u*)(raw_ + 16384 + (bt * 128 + bd) * 2) = r1; } while (0)
    HG_L(0);
    HG_W(0); HG_L(1);
    LDS_BAR();
    hg_estage(lds, lds + HG_TILE0, d, tq); HG_W(1); HG_L(2);
    LDS_BAR();
    f32x4 oprev = {0.f, 0.f, 0.f, 0.f}; unsigned short gprev[4] = {0, 0, 0, 0};
    for (int i = 0; i <= 128; ++i) {
        if (i > 0 && (i > 1 || b == 0)) {
            const int row0 = HG_ROW0(i - 1); const LAS float* SSp = (const LAS float*)(lds + HG_SS0 + ((i - 1) & 1) * 512);
            f32x4 tot = {0.f, 0.f, 0.f, 0.f};
#pragma unroll
            for (int ww = 0; ww < 8; ++ww) tot += *(const LAS f32x4*)(SSp + ww * 16 + 4 * fq);
#pragma unroll
            for (int r = 0; r < 4; ++r) { const float rstd = rsqrtf(tot[r] * (1.0f / 128.0f) + EPS);
                MIX[(size_t)(row0 + 4 * fq + r) * 2048 + h * 128 + e0 + fr] = (bf16)cvtpk(oprev[r] * rstd * gn * __uint_as_float((unsigned)gprev[r] << 16), 0.f); }
        }
        if (i + 2 <= 128) HG_W(i + 2);
        if (i + 3 <= 128) HG_L(i + 3);
        { const int row0 = HG_ROW0(i);
#pragma unroll
          for (int r = 0; r < 4; ++r) gprev[r] = GS[(size_t)(row0 + 4 * fq + r) * 1024 + h * 128 + e0 + fr]; }
        hg_estage(lds + ((i + 1) & 1) * HG_RAW, lds + HG_TILE0 + ((i + 1) & 1) * HG_TILE, d, tq);
        oprev = hg_mstage(lds + HG_TILE0 + (i & 1) * HG_TILE, (LAS float*)(lds + HG_SS0 + (i & 1) * 512), S, w, fr, fq);
        LDS_BAR();
    }
    {
        const int row0 = HG_ROW0(128); const LAS float* SSp = (const LAS float*)(lds + HG_SS0);
        f32x4 tot = {0.f, 0.f, 0.f, 0.f};
#pragma unroll
        for (int ww = 0; ww < 8; ++ww) tot += *(const LAS f32x4*)(SSp + ww * 16 + 4 * fq);
#pragma unroll
        for (int r = 0; r < 4; ++r) { const float rstd = rsqrtf(tot[r] * (1.0f / 128.0f) + EPS);
            MIX[(size_t)(row0 + 4 * fq + r) * 2048 + h * 128 + e0 + fr] = (bf16)cvtpk(oprev[r] * rstd * gn * __uint_as_float((unsigned)gprev[r] << 16), 0.f); }
    }
#undef HG_ROW0
#undef HG_L
#undef HG_W
    __syncthreads();
}

__device__ __forceinline__ void s5_item(LAS unsigned char* ldsw, int b, int g, int lane, const bf16* UY, bf16* YO, const float* S5A, const float* S5B, const float* cre, const float* cim, const float* dsk) {
    LAS bf16* Xs = (LAS bf16*)ldsw;
    LAS float* Us = (LAS float*)(ldsw + 4352);
    LAS float* BuT = (LAS float*)(ldsw + 5376);
    const int p = lane, fr = lane & 15, fq = lane >> 4;
    const float ar = S5A[(g * 64 + p) * 2], ai = S5A[(g * 64 + p) * 2 + 1];
    bf16x8 bfr[8], cf[4];
#pragma unroll
    for (int nt = 0; nt < 8; ++nt) { const int col = 16 * nt + fr, pp = col & 63, part = col >> 6;
#pragma unroll
        for (int j = 0; j < 8; ++j) { const float val = fq < 2 ? S5B[((size_t)(g * 64 + pp) * 16 + 8 * fq + j) * 2 + part] : 0.f; bfr[nt][j] = (short)f2bf(val); } }
#pragma unroll
    for (int ks = 0; ks < 4; ++ks)
#pragma unroll
        for (int j = 0; j < 8; ++j) { const int k = 32 * ks + 8 * fq + j; const float val = k < 64 ? cre[(size_t)(g * 16 + fr) * 64 + k] : -cim[(size_t)(g * 16 + fr) * 64 + (k - 64)]; cf[ks][j] = (short)f2bf(val); }
    const float dv = dsk[g * 16 + fr];
    float xr = 0.f, xi = 0.f;
    const int ucol = g * 16 + 8 * (fq & 1);
    v4u ru = {0u, 0u, 0u, 0u};
    if (fq < 2) ru = *(const v4u*)(UY + (size_t)(META0 + fr) * 1024 + ucol);
    for (int c = 0; c <= 128; ++c) {
        const int row0 = c == 0 ? META0 : b * SEQ + 16 * (c - 1);
        const bf16x8 ua = __builtin_bit_cast(bf16x8, ru);
        if (fq < 2) { LAS float* q = Us + fr * 16 + 8 * fq; *(LAS f32x4*)q = (f32x4){bflo(ru.x), bfhi(ru.x), bflo(ru.y), bfhi(ru.y)}; *(LAS f32x4*)(q + 4) = (f32x4){bflo(ru.z), bfhi(ru.z), bflo(ru.w), bfhi(ru.w)}; }
        if (c < 128 && fq < 2) ru = *(const v4u*)(UY + (size_t)(b * SEQ + 16 * c + fr) * 1024 + ucol);
#pragma unroll
        for (int nt = 0; nt < 8; ++nt) { f32x4 acc = {0.f, 0.f, 0.f, 0.f}; acc = __builtin_amdgcn_mfma_f32_16x16x32_bf16(ua, bfr[nt], acc, 0, 0, 0);
#pragma unroll
            for (int r = 0; r < 4; ++r) BuT[(4 * fq + r) * 132 + 16 * nt + fr] = acc[r]; }
        LDS_WAIT(); asm volatile("" ::: "memory");
#pragma unroll
        for (int t = 0; t < 16; ++t) {
            const float bur = BuT[t * 132 + p], bui = BuT[t * 132 + 64 + p];
            const float nxr = ar * xr - ai * xi + bur, nxi = ar * xi + ai * xr + bui; xr = nxr; xi = nxi;
            Xs[t * 136 + p] = (bf16)f2bf(xr); Xs[t * 136 + 64 + p] = (bf16)f2bf(xi);
        }
        LDS_WAIT(); asm volatile("" ::: "memory");
        f32x4 acc = {0.f, 0.f, 0.f, 0.f};
#pragma unroll
        for (int ks = 0; ks < 4; ++ks) { const bf16x8 af = *(const LAS bf16x8*)(Xs + fr * 136 + 32 * ks + 8 * fq); acc = __builtin_amdgcn_mfma_f32_16x16x32_bf16(af, cf[ks], acc, 0, 0, 0); }
#pragma unroll
        for (int r = 0; r < 4; ++r) { const int t = 4 * fq + r; const float uu = Us[t * 16 + fr]; float y = acc[r] + dv * uu;
            const float in = 1.5957691216f * (y + 0.044715f * y * y * y); y = y * __builtin_amdgcn_rcpf(1.0f + __expf(-in));
            if (c > 0 || b == 0) YO[(size_t)(row0 + t) * 1024 + g * 16 + fr] = (bf16)f2bf(y); }
        LDS_WAIT(); asm volatile("" ::: "memory");
    }
}

__device__ __forceinline__ f32x4 meta_kloop(const bf16* W, const bf16* X, int K, int wave, int fr, int fq, int ks0 = 0, int ks1 = -1) {
    f32x4 acc = {0.f, 0.f, 0.f, 0.f};
    const bf16* wp = W + (size_t)fr * K + 8 * fq; const bf16* xp = X + (size_t)fr * K + 8 * fq;
    const int nks = ks1 < 0 ? (K >> 5) : ks1;
#pragma unroll 4
    for (int ks = ks0 + wave; ks < nks; ks += 8) { const bf16x8 a = *(const bf16x8*)(wp + 32 * ks), b = *(const bf16x8*)(xp + 32 * ks); acc = __builtin_amdgcn_mfma_f32_16x16x32_bf16(a, b, acc, 0, 0, 0); }
    return acc;
}
__device__ __forceinline__ f32x4 meta_reduce(LAS float* red, f32x4 acc, int wave, int lane) {
    *(LAS f32x4*)(red + (wave * 64 + lane) * 4) = acc;
    __syncthreads();
    f32x4 s = {0.f, 0.f, 0.f, 0.f};
    if (wave == 0) {
#pragma unroll
        for (int w = 0; w < 8; ++w) s += *(const LAS f32x4*)(red + (w * 64 + lane) * 4);
    }
    __syncthreads();
    return s;
}
struct MetaP { const bf16* W; const bf16* X; int N, K; const float* rs; const float* lb; bf16* Q; bf16* Kb; float* LF; bf16* V; bf16* GS; bf16* U;
               const bf16* Y; const float* bias; bf16* MIX; float* rsacc; const float* rs5; float* hmeta; bf16* HB; bf16* Hd; const float* cw; const float* cb; float* metaA; };
template <int MODE> __device__ __forceinline__ void meta_gemm(LAS unsigned char* lds, const MetaP& P) {
    int tid = threadIdx.x; asm volatile("" : "+v"(tid));
    const int lane = tid & 63, wave = __builtin_amdgcn_readfirstlane(tid >> 6), fr = lane & 15, fq = lane >> 4;
    LAS float* red = (LAS float*)lds; LAS float* red2 = red + 2048;
    const int ntiles = (MODE == 3 ? DFF : P.N) / 16, row = META0 + fr;
    for (int nt = blockIdx.x; nt < ntiles; nt += gridDim.x) {
        const int n0 = 16 * nt;
        if (MODE == 3) {
            const int grow = 256 * (n0 >> 7) + (n0 & 127);
            f32x4 ag = meta_kloop(P.W + (size_t)grow * P.K, P.X, P.K, wave, fr, fq), au = meta_kloop(P.W + (size_t)(grow + 128) * P.K, P.X, P.K, wave, fr, fq);
            ag = meta_reduce(red, ag, wave, lane); au = meta_reduce(red2, au, wave, lane);
            if (wave == 0) {
                const float rstd = rsqrtf(P.rs[row] * (1.0f / 2048.0f) + EPS); const int f = n0 + 4 * fq;
                const f32x4 a = ag * rstd, up = au * rstd;
                f32x4 p1, p2;
#pragma unroll
                for (int r = 0; r < 4; ++r) { const float s1 = __shfl(a[r], (lane - 1) & 63), s2 = __shfl(a[r], (lane - 2) & 63); p1[r] = fr >= 1 ? s1 : 0.f; p2[r] = fr >= 2 ? s2 : 0.f; }
                const f32x4 w0 = *(const f32x4*)(P.cw + f), w1 = *(const f32x4*)(P.cw + DFF + f), w2 = *(const f32x4*)(P.cw + 2 * DFF + f), bb = *(const f32x4*)(P.cb + f);
                const f32x4 cv = bb + w0 * p2 + w1 * p1 + w2 * a;
                v2u w; w.x = cvtpk(pg8::silu_f(cv[0]) * up[0], pg8::silu_f(cv[1]) * up[1]); w.y = cvtpk(pg8::silu_f(cv[2]) * up[2], pg8::silu_f(cv[3]) * up[3]);
                *(v2u*)(P.Hd + (size_t)row * DFF + f) = w;
                if (fr >= 14) *(f32x4*)(P.metaA + (size_t)(fr - 14) * DFF + f) = a;
            }
        } else {
            f32x4 acc;
            if (MODE == 2 && P.rs5) {
                f32x4 a0 = meta_kloop(P.W + (size_t)n0 * P.K, P.X, P.K, wave, fr, fq, 0, P.K >> 6), a1 = meta_kloop(P.W + (size_t)n0 * P.K, P.X, P.K, wave, fr, fq, P.K >> 6, P.K >> 5);
                a0 = meta_reduce(red, a0, wave, lane); a1 = meta_reduce(red2, a1, wave, lane);
                acc = a0 + a1 * rsqrtf(P.rs5[row] * (1.0f / 1024.0f) + EPS);
            } else {
                acc = meta_kloop(P.W + (size_t)n0 * P.K, P.X, P.K, wave, fr, fq);
                acc = meta_reduce(red, acc, wave, lane); }
            if (wave == 0) {
                if (MODE == 0) {
                    const int seg = n0 >> 10, c = (n0 & 1023) + 4 * fq; const size_t off = (size_t)row * 1024 + c;
                    const float rstd = rsqrtf(P.rs[row] * (1.0f / 2048.0f) + EPS);
                    f32x4 v = acc * rstd;
                    if (seg == 1) { const f32x4 l = *(const f32x4*)(P.lb + c); f32x4 kk, lf; float tk, tf;
                        pg8::EpiIn::fgate(v[0], l[0], tk, tf); kk[0] = tk; lf[0] = tf; pg8::EpiIn::fgate(v[1], l[1], tk, tf); kk[1] = tk; lf[1] = tf;
                        pg8::EpiIn::fgate(v[2], l[2], tk, tf); kk[2] = tk; lf[2] = tf; pg8::EpiIn::fgate(v[3], l[3], tk, tf); kk[3] = tk; lf[3] = tf;
                        *(f32x4*)(P.LF + off) = lf; v = kk; }
                    else if (seg == 0 || seg == 3) v = (f32x4){pg8::silu_f(v[0]), pg8::silu_f(v[1]), pg8::silu_f(v[2]), pg8::silu_f(v[3])};
                    bf16* dst = seg == 0 ? P.Q : (seg == 1 ? P.Kb : (seg == 2 ? P.V : (seg == 3 ? P.GS : P.U)));
                    v2u w; w.x = cvtpk(v[0], v[1]); w.y = cvtpk(v[2], v[3]); *(v2u*)(dst + off) = w;
                } else if (MODE == 1) {
                    const int c = n0 + 4 * fq; const v2u yw = *(const v2u*)(P.Y + (size_t)row * 1024 + c); const f32x4 b4 = *(const f32x4*)(P.bias + c);
                    const f32x4 y = {bflo(yw.x), bfhi(yw.x), bflo(yw.y), bfhi(yw.y)}; f32x4 o;
#pragma unroll
                    for (int r = 0; r < 4; ++r) o[r] = y[r] * pg8::sigmoid_f(acc[r] + b4[r]);
                    v2u w; w.x = cvtpk(o[0], o[1]); w.y = cvtpk(o[2], o[3]); *(v2u*)(P.MIX + (size_t)row * 2048 + 1024 + c) = w;
                    float ss = (o[0] * o[0] + o[1] * o[1]) + (o[2] * o[2] + o[3] * o[3]); ss += __shfl_xor(ss, 16); ss += __shfl_xor(ss, 32);
                    if (fq == 0) atomicAdd(P.rsacc + row, ss);
                } else {
                    const int c = n0 + 4 * fq; bf16* hp = P.HB + (size_t)row * 2048 + c; const v2u hw = *(const v2u*)hp;
                    const f32x4 o = (f32x4){bflo(hw.x), bfhi(hw.x), bflo(hw.y), bfhi(hw.y)} + acc;
                    v2u w; w.x = cvtpk(o[0], o[1]); w.y = cvtpk(o[2], o[3]); *(v2u*)hp = w;
                    float ss = (o[0] * o[0] + o[1] * o[1]) + (o[2] * o[2] + o[3] * o[3]); ss += __shfl_xor(ss, 16); ss += __shfl_xor(ss, 32);
                    if (fq == 0) atomicAdd(P.rsacc + row, ss);
                }
            }
        }
    }
    __syncthreads();
}
#define XB_TMO      128
#define XB_XCNT(j)  (256  + 64 * (j))
#define XB_XSUB(j)  (1280 + 64 * (j))
#define XB_XGEN(j)  (2304 + 64 * (j))
#define XB_TOP      3328
#define XB_TOPGEN   3392
#define XCD_BAR_WORDS 3456
#define XB_SPIN_CAP (1u << 18)

__device__ __forceinline__ unsigned xb_ld(unsigned* p)              { return __hip_atomic_load(p, __ATOMIC_RELAXED, __HIP_MEMORY_SCOPE_AGENT); }
__device__ __forceinline__ unsigned xb_add(unsigned* p, unsigned v) { return __hip_atomic_fetch_add(p, v, __ATOMIC_RELAXED, __HIP_MEMORY_SCOPE_AGENT); }
__device__ __forceinline__ unsigned xb_xcc_id() { return (unsigned)__builtin_amdgcn_s_getreg((3 << 11) | 20) & 0xFu; }
#define XB_SPIN(cond, bar) do { unsigned _sp = 0; while (cond) { __builtin_amdgcn_s_sleep(1); \
    if ((++_sp & 255u) == 0u) { if (xb_ld(&(bar)[XB_TMO])) break; if (_sp > XB_SPIN_CAP) { atomicAdd(&(bar)[XB_TMO], 1u); break; } } } } while (0)

struct XcdBarrier {
    unsigned* bar; unsigned x;
    volatile LAS unsigned* st;
};

__device__ __forceinline__ XcdBarrier xcd_barrier_post(unsigned* bar, volatile LAS unsigned* st) {
    XcdBarrier b; b.bar = bar; b.x = xb_xcc_id(); b.st = st;
    if (threadIdx.x == 0) (void)xb_add(&bar[XB_XCNT(b.x)], 1u);
    return b;
}
__device__ __forceinline__ void xcd_barrier_complete(unsigned* bar, unsigned x, unsigned& nloc, unsigned& nx) {
    const unsigned G = gridDim.x * gridDim.y * gridDim.z;
    unsigned sum, cnt, mine, sp = 0u;
    for (;;) {
        sum = 0u; cnt = 0u; mine = 0u;
#pragma unroll
        for (unsigned j = 0; j < 16; ++j) { const unsigned c = xb_ld(&bar[XB_XCNT(j)]); sum += c; cnt += (c > 0u) ? 1u : 0u; mine = (j == x) ? c : mine; }
        if (sum == G) break;
        __builtin_amdgcn_s_sleep(1);
        if ((++sp & 255u) == 0u) { if (xb_ld(&bar[XB_TMO])) break; if (sp > XB_SPIN_CAP) { atomicAdd(&bar[XB_TMO], 1u); break; } }
    }
    nloc = mine > 0u ? mine : 1u; nx = cnt > 0u ? cnt : 1u;
}

__device__ __forceinline__ void xcd_barrier(const XcdBarrier& b) {
    asm volatile("s_waitcnt vmcnt(0)" ::: "memory");
    __syncthreads();
    if (threadIdx.x == 0) {
        unsigned* bar = b.bar;
        __builtin_amdgcn_s_waitcnt(0);
        unsigned nloc = b.st[0], nx = b.st[1];
        if (nloc == 0u) { xcd_barrier_complete(bar, b.x, nloc, nx); b.st[0] = nloc; b.st[1] = nx; }
        const unsigned old = xb_add(&bar[XB_XSUB(b.x)], 1u);
        const unsigned gen = old / nloc;
        if (old + 1u == (gen + 1u) * nloc) {
            __builtin_amdgcn_fence(__ATOMIC_RELEASE, "agent");
            asm volatile("s_waitcnt vmcnt(0)" ::: "memory");
            const unsigned og = xb_add(&bar[XB_TOP], 1u);
            const unsigned tg = og / nx;
            if (og + 1u == (tg + 1u) * nx) xb_add(&bar[XB_TOPGEN], 1u);
            else XB_SPIN(xb_ld(&bar[XB_TOPGEN]) == tg, bar);
            __builtin_amdgcn_fence(__ATOMIC_ACQUIRE, "agent");
            xb_add(&bar[XB_XGEN(b.x)], 1u);
            asm volatile("s_waitcnt vmcnt(0)" ::: "memory");
        } else {
            XB_SPIN(xb_ld(&bar[XB_XGEN(b.x)]) == gen, bar);
            __builtin_amdgcn_fence(__ATOMIC_ACQUIRE, "agent");
            asm volatile("s_waitcnt vmcnt(0)" ::: "memory");
        }
    }
    __syncthreads();
}
#ifndef ONE_LAUNCH
#define ONE_LAUNCH 1
#endif
#ifndef ONLY
#define ONLY -1
#endif
#define PH_ON(k) (ONLY == -1 || ONLY == (k))
#ifndef REP_MIX
#define REP_MIX 1
#endif
#ifndef REP_HG
#define REP_HG 1
#endif
#ifndef REP_S5
#define REP_S5 1
#endif
#ifndef REP_P5
#define REP_P5 1
#endif
#ifndef REP_P1
#define REP_P1 1
#endif
#ifndef REP_P0
#define REP_P0 1
#endif
constexpr int NPHASES = 18;

#define IN(k) (lo <= (k) && (k) < hi)
#define SEAM(k) do { if (IN(k) && IN((k) + 1)) { if ((k) == 0) cg::this_grid().sync(); else xcd_barrier(xbar); } } while (0)

template <int L> __device__ __forceinline__ void layer_phases(const Args& args, LAS unsigned char* lds, const int lo, const int hi, const XcdBarrier& xbar) {
    constexpr int P = 1 + 8 * L;
    unsigned char* const ws = args.ws;
    const int G = gridDim.x;
    if (IN(P + 0) && PH_ON(0)) {
        unsigned char* wl = ws + WS_W + (size_t)L * W_LAYER; float* RS = (float*)(ws + WS_CTL);
        { MetaP mp{}; mp.W = (const bf16*)(wl + W_IN); mp.X = (const bf16*)(ws + WS_HB) + (size_t)META0 * DM; mp.N = DIN; mp.K = DM; mp.rs = RS + (2 * L) * RS_STRIDE; mp.lb = (const float*)(ws + WS_LB) + L * DHG;
          mp.Q = (bf16*)(ws + WS_Q); mp.Kb = (bf16*)(ws + WS_K); mp.LF = (float*)(ws + WS_LF); mp.V = (bf16*)(ws + WS_V); mp.GS = (bf16*)(ws + WS_GS); mp.U = (bf16*)(ws + WS_U); meta_gemm<0>(lds, mp); }
        pg8::Gemm g{(const bf16*)(ws + WS_HB), (const bf16*)(wl + W_IN), MMAIN, DIN, DM}; pg8::StaticOrder S; S.init(MMAIN, DIN, G, (int)blockIdx.x);
        pg8::EpiIn E{RS + (2 * L) * RS_STRIDE, (const float*)(ws + WS_LB) + L * DHG, (bf16*)(ws + WS_Q), (bf16*)(ws + WS_K), (float*)(ws + WS_LF), (bf16*)(ws + WS_V), (bf16*)(ws + WS_GS), (bf16*)(ws + WS_U)};
        for (int rep = 0; rep < REP_P1; ++rep) pg8::gemm_phase<pg8::EpiIn, pg8::StaticOrder, true, true>(lds, g, S, E);
    }
    SEAM(P + 0);
    if (IN(P + 1) && PH_ON(1)) {
        int tid = threadIdx.x; asm volatile("" : "+v"(tid));
        const int lane = tid & 63, wave = __builtin_amdgcn_readfirstlane(tid >> 6);
        for (int rep = 0; rep < REP_MIX; ++rep)
        for (int it = blockIdx.x; it < 256; it += G) {
            if (it < 128) for (int r2 = 0; r2 < REP_HG; ++r2) hgrn2_item(lds, tid, it >> 3, it & 7, (const bf16*)(ws + WS_Q), (const bf16*)(ws + WS_K), (const float*)(ws + WS_LF), (const bf16*)(ws + WS_V), (const bf16*)(ws + WS_GS), (bf16*)(ws + WS_MIX), args.in[5] + L * DHG);
            else { const int idx = (it - 128) * 8 + wave;
                for (int r2 = 0; r2 < REP_S5; ++r2) s5_item(lds + wave * 14336, idx >> 6, idx & 63, lane, (const bf16*)(ws + WS_U), (bf16*)(ws + WS_Y), (const float*)(ws + WS_S5A) + L * 64 * 64 * 2, (const float*)(ws + WS_S5B) + (size_t)L * 64 * 64 * 32,
                        args.in[11] + (size_t)L * 64 * 16 * 64, args.in[12] + (size_t)L * 64 * 16 * 64, args.in[13] + L * DS5);
                __syncthreads(); }
        }
    }
    SEAM(P + 1);
    if (IN(P + 2) && PH_ON(2)) {
        unsigned char* wl = ws + WS_W + (size_t)L * W_LAYER; float* RS = (float*)(ws + WS_CTL);
        { MetaP mp{}; mp.W = (const bf16*)(wl + W_GLU); mp.X = (const bf16*)(ws + WS_Y) + (size_t)META0 * DS5; mp.N = DS5; mp.K = DS5; mp.Y = (const bf16*)(ws + WS_Y); mp.bias = args.in[15] + L * DS5; mp.MIX = (bf16*)(ws + WS_MIX); mp.rsacc = RS + (5 + L) * RS_STRIDE; meta_gemm<1>(lds, mp); }
        pg8::Gemm g{(const bf16*)(ws + WS_Y), (const bf16*)(wl + W_GLU), MMAIN, DS5, DS5}; pg8::StaticOrder S; S.init(MMAIN, DS5, G, (int)blockIdx.x);
        pg8::EpiGlu E{(const bf16*)(ws + WS_Y), args.in[15] + L * DS5, (bf16*)(ws + WS_MIX), RS + (5 + L) * RS_STRIDE};
        pg8::gemm_phase<pg8::EpiGlu, pg8::StaticOrder, true, true>(lds, g, S, E);
    }
    SEAM(P + 2);
    if (IN(P + 4) && PH_ON(4)) {
        unsigned char* wl = ws + WS_W + (size_t)L * W_LAYER; float* RS = (float*)(ws + WS_CTL);
        { MetaP mp{}; mp.W = (const bf16*)(wl + W_OUT); mp.X = (const bf16*)(ws + WS_MIX) + (size_t)META0 * DM; mp.N = DM; mp.K = DM; mp.rsacc = RS + (2 * L + 1) * RS_STRIDE; mp.rs5 = RS + (5 + L) * RS_STRIDE; mp.hmeta = (float*)(ws + WS_HMETA); mp.HB = (bf16*)(ws + WS_HB); meta_gemm<2>(lds, mp); }
        pg8::Gemm g{(const bf16*)(ws + WS_MIX), (const bf16*)(wl + W_OUT), MMAIN, DM, DM}; pg8::StaticOrder S; S.init(MMAIN, DM, G, (int)blockIdx.x);
        pg8::EpiResT<true> E{nullptr, (bf16*)(ws + WS_HB), RS + (2 * L + 1) * RS_STRIDE, RS + (5 + L) * RS_STRIDE};
        pg8::gemm_phase<pg8::EpiResT<true>, pg8::StaticOrder, true, true>(lds, g, S, E);
    }
    SEAM(P + 4);
    if (IN(P + 5) && PH_ON(5)) {
        unsigned char* wl = ws + WS_W + (size_t)L * W_LAYER; float* RS = (float*)(ws + WS_CTL);
        { MetaP mp{}; mp.W = (const bf16*)(wl + W_GU); mp.X = (const bf16*)(ws + WS_HB) + (size_t)META0 * DM; mp.N = 2 * DFF; mp.K = DM; mp.rs = RS + (2 * L + 1) * RS_STRIDE; mp.Hd = (bf16*)(ws + WS_HID); mp.cw = args.in[21] + (size_t)L * 3 * DFF; mp.cb = args.in[22] + L * DFF; mp.metaA = (float*)(ws + WS_METAA); meta_gemm<3>(lds, mp); }
        pg8::Gemm g{(const bf16*)(ws + WS_HB), (const bf16*)(wl + W_GU), MMAIN, 2 * DFF, DM}; pg8::StaticOrder S; S.init(MMAIN, 2 * DFF, G, (int)blockIdx.x);
        pg8::EpiGU E{RS + (2 * L + 1) * RS_STRIDE, (bf16*)(ws + WS_HID), args.in[21] + (size_t)L * 3 * DFF, args.in[22] + L * DFF, (float*)(ws + WS_SIDEA), (float*)(ws + WS_SIDEU), (float*)(ws + WS_METAA)};
        for (int rep = 0; rep < REP_P5; ++rep) pg8::gemm_phase<pg8::EpiGU, pg8::StaticOrder, true, true>(lds, g, S, E);
    }
    SEAM(P + 5);
    if (IN(P + 6) && PH_ON(6)) {
        int tid = threadIdx.x; asm volatile("" : "+v"(tid));
        const float* cw = args.in[21] + (size_t)L * 3 * DFF; const float* cb = args.in[22] + L * DFF;
        const float* sideA = (const float*)(ws + WS_SIDEA); const float* sideU = (const float*)(ws + WS_SIDEU); const float* metaA = (const float*)(ws + WS_METAA); bf16* HID = (bf16*)(ws + WS_HID);
        const int gt = blockIdx.x * NTHREADS + tid, NGT = G * NTHREADS; constexpr int F4 = DFF / 4;
        for (int i = gt; i < 512 * 2 * F4; i += NGT) {
            const int f = (i % F4) * 4, sr = i / F4, r = sr & 1, seg = sr >> 1;
            const f32x4 a0 = *(const f32x4*)(sideA + (size_t)(seg * 4 + 0) * DFF + f), a1 = *(const f32x4*)(sideA + (size_t)(seg * 4 + 1) * DFF + f);
            f32x4 h0, h1;
            if ((seg & 31) == 0) { h0 = *(const f32x4*)(metaA + f); h1 = *(const f32x4*)(metaA + DFF + f); }
            else { h0 = *(const f32x4*)(sideA + (size_t)((seg - 1) * 4 + 2) * DFF + f); h1 = *(const f32x4*)(sideA + (size_t)((seg - 1) * 4 + 3) * DFF + f); }
            const f32x4 cur = r ? a1 : a0, p1 = r ? a0 : h1, p2 = r ? h1 : h0;
            const f32x4 w0 = *(const f32x4*)(cw + f), w1 = *(const f32x4*)(cw + DFF + f), w2 = *(const f32x4*)(cw + 2 * DFF + f), bb = *(const f32x4*)(cb + f);
            const f32x4 up = *(const f32x4*)(sideU + (size_t)(seg * 2 + r) * DFF + f);
            const f32x4 cv = bb + w0 * p2 + w1 * p1 + w2 * cur;
            v2u w; w.x = pk2(pg8::silu_f(cv[0]) * up[0], pg8::silu_f(cv[1]) * up[1]); w.y = pk2(pg8::silu_f(cv[2]) * up[2], pg8::silu_f(cv[3]) * up[3]);
            *(v2u*)(HID + (size_t)(seg * 64 + r) * DFF + f) = w;
        }
    }
    SEAM(P + 6);
    if (IN(P + 7) && PH_ON(7)) {
        unsigned char* wl = ws + WS_W + (size_t)L * W_LAYER; float* RS = (float*)(ws + WS_CTL);
        { MetaP mp{}; mp.W = (const bf16*)(wl + W_DN); mp.X = (const bf16*)(ws + WS_HID) + (size_t)META0 * DFF; mp.N = DM; mp.K = DFF; mp.rsacc = RS + (2 * L + 2) * RS_STRIDE; mp.hmeta = (float*)(ws + WS_HMETA); mp.HB = (bf16*)(ws + WS_HB); meta_gemm<2>(lds, mp); }
        pg8::Gemm g{(const bf16*)(ws + WS_HID), (const bf16*)(wl + W_DN), MMAIN, DM, DFF}; pg8::StaticOrder S; S.init(MMAIN, DM, G, (int)blockIdx.x);
        pg8::EpiResT<false> E{L == DEPTH - 1 ? args.out : nullptr, (bf16*)(ws + WS_HB), RS + (2 * L + 2) * RS_STRIDE, nullptr};
        pg8::gemm_phase<pg8::EpiResT<false>, pg8::StaticOrder, true, true>(lds, g, S, E);
    }
    SEAM(P + 7);
}

__global__ void __launch_bounds__(NTHREADS) fwd_kernel(Args args) {
    extern __shared__ __attribute__((aligned(16))) unsigned char lds_raw[];
    LAS unsigned char* lds = (LAS unsigned char*)lds_raw;
    const int lo = args.ph_lo, hi = args.ph_hi;
    volatile LAS unsigned* xst = (volatile LAS unsigned*)(lds + LDS_BYTES - 64);
    if (threadIdx.x < 2) xst[threadIdx.x] = 0u;
    __syncthreads();
    const XcdBarrier xbar = xcd_barrier_post((unsigned*)(args.ws + WS_CTL + WS_BAR_OFF), xst);
    if (IN(0) && PH_ON(100)) { for (int rep = 0; rep < REP_P0; ++rep) p0_prologue(args, lds); }
    SEAM(0);
    layer_phases<0>(args, lds, lo, hi, xbar);
    layer_phases<1>(args, lds, lo, hi, xbar);
    if (IN(NPHASES - 1) && PH_ON(101)) {
        int tid = threadIdx.x; asm volatile("" : "+v"(tid));
        const int lane = tid & 63, wave = tid >> 6;
        const int gw = blockIdx.x * NWAVES + wave, NGW = gridDim.x * NWAVES; const float* rs = (const float*)(args.ws + WS_CTL) + 4 * RS_STRIDE; const float* gn = args.in[24];
        for (int m = gw; m < MMAIN; m += NGW) {
            const float rstd = rsqrtf(rs[m] * (1.0f / 2048.0f) + EPS); float* row = args.out + (size_t)m * DM;
#pragma unroll
            for (int j = 0; j < 8; ++j) { const f32x4 v = *(const f32x4*)(row + 4 * lane + 256 * j), g4 = *(const f32x4*)(gn + 4 * lane + 256 * j); *(f32x4*)(row + 4 * lane + 256 * j) = v * rstd * g4; }
        }
    }
}
#undef IN
#undef SEAM

extern "C" void kernel_launch(void* const* d_in, const int* in_sizes, int n_in, void* d_out, int out_size, void* d_ws, size_t ws_size, hipStream_t stream) {
    static int grid = 0;
    if (grid == 0) {
        if (n_in != 25 || out_size != MMAIN * DM || ws_size < WS_END) { fprintf(stderr, "kernel_launch: unexpected shapes (n_in %d, out %d, ws %zu < %zu)\n", n_in, out_size, ws_size, (size_t)WS_END); grid = -1; return; }
        int dev = 0, cus = 0, per_cu = 0;
        hipGetDevice(&dev); hipDeviceGetAttribute(&cus, hipDeviceAttributeMultiprocessorCount, dev);
        if (hipFuncSetAttribute((const void*)fwd_kernel, hipFuncAttributeMaxDynamicSharedMemorySize, LDS_BYTES) != hipSuccess) { fprintf(stderr, "kernel_launch: hipFuncSetAttribute failed\n"); grid = -1; return; }
        if (hipOccupancyMaxActiveBlocksPerMultiprocessor(&per_cu, (const void*)fwd_kernel, NTHREADS, LDS_BYTES) != hipSuccess || per_cu < 1) { fprintf(stderr, "kernel_launch: occupancy query gave %d\n", per_cu); per_cu = 1; }
        (void)hipGetLastError();
        grid = cus * 1;
    }
    if (grid < 0) return;
    hipMemsetAsync((char*)d_ws + WS_CTL, 0, CTL_ZERO_BYTES, stream);
    Args a{};
    for (int i = 0; i < 25; ++i) a.in[i] = (const float*)d_in[i];
    a.out = (float*)d_out; a.ws = (unsigned char*)d_ws;
#if ONE_LAUNCH
    a.ph_lo = 0; a.ph_hi = NPHASES;
    void* kargs[] = {&a};
    hipError_t e = hipLaunchCooperativeKernel((const void*)fwd_kernel, dim3(grid), dim3(NTHREADS), kargs, LDS_BYTES, stream);
    if (e != hipSuccess) fprintf(stderr, "kernel_launch: cooperative launch failed: %s (grid %d)\n", hipGetErrorString(e), grid);
#else
    for (int ph = 0; ph < NPHASES; ++ph) { a.ph_lo = ph; a.ph_hi = ph + 1; hipLaunchKernelGGL(fwd_kernel, dim3(grid), dim3(NTHREADS), LDS_BYTES, stream, a); }
#endif
}
```
